# Optimizing an MI355X kernel written in HIP

```python
import jax, jax.numpy as jnp
from jax import lax
import numpy as np

D_MODEL = 2048
BATCH = 8
SEQ = 2048
DEPTH = 1

RET_HEADS = 8
RET_HEAD_DIM = 256
D_RET = RET_HEADS * RET_HEAD_DIM
CONV_GROUPS = 8
D_CONV = D_MODEL
CONV_WIDTH = 3
D_FF = 5632
CHUNK = 128
ROPE_BASE = 10000.0
EPS = 1e-6
N_BRANCHES = 2
IN_COLS = 4 * D_RET + 3 * D_CONV + N_BRANCHES * D_MODEL

kernel_name = "hybrid_retention_shortconv_convffn_adaln"


def _rmsnorm(x, g):
    xf = x.astype(jnp.float32)
    r = xf * lax.rsqrt(jnp.mean(xf * xf, axis=-1, keepdims=True) + EPS)
    return (r * g.astype(jnp.float32)).astype(x.dtype)


def _causal_dwconv(u, w, b=None):
    s = u.shape[1]
    up = jnp.pad(u, ((0, 0), (CONV_WIDTH - 1, 0), (0, 0)))
    y = sum(w[k] * up[:, k:k + s, :] for k in range(CONV_WIDTH))
    if b is not None:
        y = y + b
    return y


def _rotary(x, positions):
    half = x.shape[-1] // 2
    inv_freq = ROPE_BASE ** (-jnp.arange(half, dtype=jnp.float32) / half)
    ang = positions.astype(jnp.float32)[..., None] * inv_freq
    cos = jnp.cos(ang)[:, :, None, :].astype(x.dtype)
    sin = jnp.sin(ang)[:, :, None, :].astype(x.dtype)
    x1, x2 = x[..., :half], x[..., half:]
    return jnp.concatenate([x1 * cos - x2 * sin, x2 * cos + x1 * sin], axis=-1)


def _retention_chunkwise(q, k, v):
    b, s, h, dh = q.shape
    n = s // CHUNK
    dt = q.dtype
    log_gamma = jnp.log(1.0 - 2.0 ** (-5.0 - jnp.arange(h, dtype=jnp.float32)))

    def chunks(t):
        return t.astype(jnp.float32).reshape(b, n, CHUNK, h, dh).transpose(1, 0, 3, 2, 4)

    qc = chunks(q) * (dh ** -0.5)
    kc, vc = chunks(k), chunks(v)

    idx = jnp.arange(CHUNK, dtype=jnp.float32)
    diff = idx[:, None] - idx[None, :]
    decay = jnp.where(diff >= 0,
                      jnp.exp(log_gamma[:, None, None] * jnp.maximum(diff, 0.0)),
                      0.0)
    scores = jnp.einsum('nbhid,nbhjd->nbhij', qc, kc) * decay
    y_inner = jnp.einsum('nbhij,nbhjd->nbhid', scores, vc)

    q_dec = jnp.exp(log_gamma[:, None] * (idx + 1.0))[None, :, :, None]
    k_dec = jnp.exp(log_gamma[:, None] * (CHUNK - 1.0 - idx))[None, :, :, None]
    chunk_dec = jnp.exp(log_gamma * CHUNK)[None, :, None, None]

    def step(state, xs):
        qn, kn, vn = xs
        y_cross = jnp.einsum('bhid,bhde->bhie', qn * q_dec, state)
        state = chunk_dec * state + jnp.einsum('bhjd,bhje->bhde', kn * k_dec, vn)
        return state, y_cross

    state0 = jnp.zeros((b, h, dh, dh), jnp.float32)
    _, y_cross = lax.scan(step, state0, (qc, kc, vc))
    y = (y_inner + y_cross).transpose(1, 0, 3, 2, 4).reshape(b, s, h, dh)
    y = y * lax.rsqrt(jnp.mean(y * y, axis=-1, keepdims=True) + EPS)
    return y.astype(dt)


def setup_inputs(seed: int = 0) -> dict:
    key = jax.random.key(seed)
    ks = jax.random.split(key, 20)
    f32 = jnp.float32

    def nrm(k, shape, fan_in):
        return jax.random.normal(k, shape, f32) * (fan_in ** -0.5)

    x = jax.random.normal(ks[0], (BATCH, SEQ, D_MODEL), f32)
    c = jax.random.normal(ks[1], (BATCH, D_MODEL), f32)
    positions = jnp.broadcast_to(jnp.arange(SEQ, dtype=jnp.int32)[None, :], (BATCH, SEQ))
    return {
        "x": x,
        "c": c,
        "positions": positions,
        "norm1_g": 1.0 + 0.02 * jax.random.normal(ks[2], (DEPTH, D_MODEL), f32),
        "norm2_g": 1.0 + 0.02 * jax.random.normal(ks[3], (DEPTH, D_MODEL), f32),
        "w_ada": nrm(ks[4], (DEPTH, D_MODEL, 6 * D_MODEL), D_MODEL),
        "b_ada": 0.02 * jax.random.normal(ks[5], (DEPTH, 6 * D_MODEL), f32),
        "w_in": nrm(ks[6], (DEPTH, D_MODEL, IN_COLS), D_MODEL),
        "b_gate": 0.02 * jax.random.normal(ks[7], (DEPTH, N_BRANCHES * D_MODEL), f32),
        "w_sc": nrm(ks[8], (DEPTH, CONV_WIDTH, D_CONV), CONV_WIDTH),
        "w_ret_o": nrm(ks[9], (DEPTH, D_RET, D_MODEL), D_RET),
        "w_conv_o": nrm(ks[10], (DEPTH, D_CONV, D_MODEL), D_CONV),
        "w_mix_o": nrm(ks[11], (DEPTH, D_MODEL, D_MODEL), D_MODEL),
        "w_up": nrm(ks[12], (DEPTH, D_MODEL, D_FF), D_MODEL),
        "w_gate": nrm(ks[13], (DEPTH, D_MODEL, D_FF), D_MODEL),
        "w_ffconv": nrm(ks[14], (DEPTH, CONV_WIDTH, D_FF), CONV_WIDTH),
        "b_ffconv": 0.02 * jax.random.normal(ks[15], (DEPTH, D_FF), f32),
        "w_down": nrm(ks[16], (DEPTH, D_FF, D_MODEL), D_FF),
        "final_g": 1.0 + 0.02 * jax.random.normal(ks[17], (D_MODEL,), f32),
    }


def reference(x, c, positions, norm1_g, norm2_g, w_ada, b_ada, w_in, b_gate, w_sc,
              w_ret_o, w_conv_o, w_mix_o, w_up, w_gate, w_ffconv, b_ffconv, w_down,
              final_g):
    b, s, _ = x.shape
    h = x
    c_act = jax.nn.silu(c)
    for l in range(DEPTH):
        mod = c_act @ w_ada[l] + b_ada[l]
        sh1, sc1, g1, sh2, sc2, g2 = [m[:, None, :] for m in jnp.split(mod, 6, axis=-1)]

        xn = _rmsnorm(h, norm1_g[l]) * (1.0 + sc1) + sh1
        proj = xn @ w_in[l]
        splits = np.cumsum([D_RET, D_RET, D_RET, D_RET, D_CONV, D_CONV, D_CONV])
        q, k, v, g_ret, bg, cg, xc, gate_logits = jnp.split(proj, splits, axis=-1)

        q = _rotary(q.reshape(b, s, RET_HEADS, RET_HEAD_DIM), positions)
        k = _rotary(k.reshape(b, s, RET_HEADS, RET_HEAD_DIM), positions)
        v = v.reshape(b, s, RET_HEADS, RET_HEAD_DIM)
        y_ret = _retention_chunkwise(q, k, v).reshape(b, s, D_RET)
        y_ret = (y_ret * jax.nn.silu(g_ret)) @ w_ret_o[l]

        y_conv = bg * _causal_dwconv(cg * xc, w_sc[l])
        y_conv = y_conv @ w_conv_o[l]

        gates = jax.nn.sigmoid(gate_logits + b_gate[l])
        gate_a, gate_b = jnp.split(gates, N_BRANCHES, axis=-1)
        mixed = (gate_a * y_ret + gate_b * y_conv) @ w_mix_o[l]
        h = h + g1 * mixed

        xn2 = _rmsnorm(h, norm2_g[l]) * (1.0 + sc2) + sh2
        up = xn2 @ w_up[l]
        gt = _causal_dwconv(xn2 @ w_gate[l], w_ffconv[l], b_ffconv[l])
        ff = (jax.nn.silu(gt) * up) @ w_down[l]
        h = h + g2 * ff
    return _rmsnorm(h, final_g)
```

```cpp
#include <hip/hip_runtime.h>
#include <hip/hip_cooperative_groups.h>
#include <cstdio>
#include <cstdint>
namespace cg = cooperative_groups;

#ifndef MK_N_LAUNCHES
#define MK_N_LAUNCHES 1
#endif

constexpr int DM = 2048, NBATCH = 8, SEQ = 2048, MTOK = NBATCH * SEQ, DFF = 5632, NHEAD = 8;
constexpr int N_A = 8192, N_D = 10240, N_UG = 2 * DFF;
constexpr float EPS = 1e-6f;
constexpr int NPHASE = 16;

namespace pg8 {
#define PG8_LAS __attribute__((address_space(3)))
typedef unsigned short bf16_t;
typedef short bf16x8 __attribute__((ext_vector_type(8)));
typedef float f32x4 __attribute__((ext_vector_type(4)));
typedef unsigned u32x4 __attribute__((ext_vector_type(4)));
constexpr int BM = 256, BK = 64, HALF = 128, HTB = HALF * BK * 2  , STAGE_BYTES = 8 * HTB, NXCD = 8, WGM = 8;

__host__ __device__ __forceinline__ int lds_byte(int r, int c) { const int st = (r >> 4) * 2 + (c >> 5), rr = r & 15, cc = c & 31, ob = rr * 64 + cc * 2; return st * 1024 + (ob ^ (((ob >> 9) & 1) << 5)); }
__host__ __device__ __forceinline__ void stage_rc(int b, int& R, int& C) { const int st = b / 1024, sb = b % 1024, swz = sb ^ (((sb >> 9) & 1) << 5); R = (st >> 1) * 16 + swz / 64; C = (st & 1) * 32 + (swz % 64) / 2; }
__host__ __device__ __forceinline__ int perm32(int rho) { const int n = rho >> 4, i = rho & 15; return 8 * (i >> 2) + 4 * n + (i & 3); }

struct Unit { int pm, pn; };
struct Gemm { const bf16_t* A; const bf16_t* Bt; int M, N, K; };

struct StaticOrder {
    int nM, nN, nwg, G, c;
    __host__ __device__ void init(int M, int N, int G_, int c_) { nM = M / BM; nN = N / BM; nwg = nM * nN; G = G_; c = c_; }
    __host__ __device__ bool next(int i, Unit& u) const {
        const long L = (long)i * G + c; if (L >= nwg) return false;
        int wgid = (int)L; { const int q = nwg / NXCD, r = nwg % NXCD, xcd = wgid % NXCD, off = wgid / NXCD; wgid = (xcd < r ? xcd * (q + 1) : r * (q + 1) + (xcd - r) * q) + off; }
        const int nig = WGM * nN, gid = wgid / nig, fm = gid * WGM, gsz = (nM - fm) < WGM ? (nM - fm) : WGM;
        u.pm = fm + ((wgid % nig) % gsz); u.pn = (wgid % nig) / gsz; return true;
    }
    __device__ __forceinline__ void a_ready(const Unit&) const {}
    __device__ __forceinline__ void done(const Unit&) const {}
};

typedef unsigned u32x2 __attribute__((ext_vector_type(2)));
typedef __bf16 bf16x2_t __attribute__((ext_vector_type(2)));
typedef float f32x2_t __attribute__((ext_vector_type(2)));
__device__ __forceinline__ unsigned cvt_pk_bf16(float lo, float hi) { const f32x2_t v = {lo, hi}; const bf16x2_t r = __builtin_convertvector(v, bf16x2_t); return __builtin_bit_cast(unsigned, r); }
__device__ __forceinline__ float bflo(unsigned u) { return __uint_as_float(u << 16); }
__device__ __forceinline__ float bfhi(unsigned u) { return __uint_as_float(u & 0xffff0000u); }
__device__ __forceinline__ float sigmoidf_(float x) { return __builtin_amdgcn_rcpf(1.0f + __expf(-x)); }
__device__ __forceinline__ void st8(bf16_t* p, const f32x4& a, const f32x4& b) {
    u32x4 o; o.x = cvt_pk_bf16(a[0], a[1]); o.y = cvt_pk_bf16(a[2], a[3]); o.z = cvt_pk_bf16(b[0], b[1]); o.w = cvt_pk_bf16(b[2], b[3]); *(u32x4*)p = o; }
__device__ __forceinline__ void ld8(const bf16_t* p, f32x4& a, f32x4& b) {
    const u32x4 v = *(const u32x4*)p; a[0] = bflo(v.x); a[1] = bfhi(v.x); a[2] = bflo(v.y); a[3] = bfhi(v.y); b[0] = bflo(v.z); b[1] = bfhi(v.z); b[2] = bflo(v.w); b[3] = bfhi(v.w); }

enum { EM_A = 0, EM_CONVO = 1, EM_D = 2, EM_RETO = 3, EM_MIXO = 4, EM_UG = 5, EM_DOWN = 6 };
template <int MODE> struct Epi {
    static constexpr bool PERM = true, AFTER_DRAIN = false;
    bf16_t* o[5];
    const bf16_t* i0; const bf16_t* i1;
    const float* f0; const float* f1; const float* f2;
    float* fo;
    __device__ __forceinline__ void operator()(const f32x4 (&acc)[2][2][4][2], const Unit& u, int wr, int wc, int fr, int fq) const {
        const int row0 = u.pm * BM + wr * 64 + fr;
        const int ct = wc * 32 + fq * 8;
        if constexpr (MODE == EM_A) {
            const int ch = u.pn * 64 + wc * 16 + fq * 4;
            const f32x4 w0 = *(const f32x4*)(f1 + ch), w1 = *(const f32x4*)(f1 + DM + ch), w2 = *(const f32x4*)(f1 + 2 * DM + ch), gbias = *(const f32x4*)(f0 + DM + ch);
#pragma unroll
            for (int ai = 0; ai < 2; ++ai) {
                const int blk = (u.pm * BM + ai * HALF + wr * 64) >> 6;
                f32x4 p1 = {0.f, 0.f, 0.f, 0.f}, p2 = p1;
#pragma unroll
                for (int m = 0; m < 4; ++m) { const size_t r = (size_t)(row0 + ai * HALF + m * 16);
                    const f32x4 p = acc[ai][0][m][1] * acc[ai][1][m][0]; f32x4 a1, a2, uu, gg = acc[ai][1][m][1] + gbias;
#pragma unroll
                    for (int e = 0; e < 4; ++e) { a1[e] = __shfl(p[e], (fq << 4) | ((fr + 15) & 15)); a2[e] = __shfl(p[e], (fq << 4) | ((fr + 14) & 15)); }
#pragma unroll
                    for (int e = 0; e < 4; ++e) { const float pv1 = fr >= 1 ? a1[e] : p1[e], pv2 = fr >= 2 ? a2[e] : p2[e];
                        uu[e] = acc[ai][0][m][0][e] * (w0[e] * pv2 + w1[e] * pv1 + w2[e] * p[e]); gg[e] = sigmoidf_(gg[e]); }
                    p1 = a1; p2 = a2;
                    { u32x2 w; w.x = cvt_pk_bf16(uu[0], uu[1]); w.y = cvt_pk_bf16(uu[2], uu[3]); *(u32x2*)(o[0] + r * DM + ch) = w; }
                    { u32x2 w; w.x = cvt_pk_bf16(gg[0], gg[1]); w.y = cvt_pk_bf16(gg[2], gg[3]); *(u32x2*)(o[2] + r * DM + ch) = w; }
                    if (m == 0 && fr < 2) { u32x2 w; w.x = cvt_pk_bf16(p[0], p[1]); w.y = cvt_pk_bf16(p[2], p[3]); *(u32x2*)(o[1] + (size_t)(blk * 2 + fr) * DM + ch) = w;
                        const f32x4 b = acc[ai][0][0][0]; w.x = cvt_pk_bf16(b[0], b[1]); w.y = cvt_pk_bf16(b[2], b[3]); *(u32x2*)(o[3] + (size_t)(blk * 2 + fr) * DM + ch) = w; }
                    if (m == 3 && fr >= 14) { u32x2 w; w.x = cvt_pk_bf16(p[0], p[1]); w.y = cvt_pk_bf16(p[2], p[3]); *(u32x2*)(o[4] + (size_t)(blk * 2 + fr - 14) * DM + ch) = w; } }
            }
        } else if constexpr (MODE == EM_CONVO) {
            const int cb = u.pn * 256 + ct;
#pragma unroll
            for (int ai = 0; ai < 2; ++ai)
#pragma unroll
                for (int m = 0; m < 4; ++m) { const size_t r = (size_t)(row0 + ai * HALF + m * 16);
#pragma unroll
                    for (int bj = 0; bj < 2; ++bj) { f32x4 g0, g1; ld8(i0 + r * DM + cb + bj * HALF, g0, g1);
                        st8(o[0] + r * DM + cb + bj * HALF, acc[ai][bj][m][0] * g0, acc[ai][bj][m][1] * g1); } }
        } else if constexpr (MODE == EM_D) {
            const int seg = u.pn >> 3, hh = u.pn & 7;
            bf16_t* O = seg == 0 ? o[0] : seg == 1 ? o[1] : seg == 2 ? o[2] : seg == 3 ? o[3] : o[4];
            if (seg < 2) {
                const float sc = seg == 0 ? 0.0625f : 1.0f;
#pragma unroll
                for (int ai = 0; ai < 2; ++ai)
#pragma unroll
                    for (int m = 0; m < 4; ++m) { const size_t r = (size_t)(row0 + ai * HALF + m * 16);
                        f32x4 c0 = *(const f32x4*)(f1 + r * 128 + ct), c1 = *(const f32x4*)(f1 + r * 128 + ct + 4);
                        f32x4 s0 = *(const f32x4*)(f2 + r * 128 + ct), s1 = *(const f32x4*)(f2 + r * 128 + ct + 4);
                        c0 *= sc; c1 *= sc; s0 *= sc; s1 *= sc;
                        const f32x4 a0 = acc[ai][0][m][0], a1 = acc[ai][0][m][1], b0 = acc[ai][1][m][0], b1 = acc[ai][1][m][1];
                        st8(O + r * DM + hh * 256 + ct, a0 * c0 - b0 * s0, a1 * c1 - b1 * s1);
                        st8(O + r * DM + hh * 256 + 128 + ct, b0 * c0 + a0 * s0, b1 * c1 + a1 * s1); }
            } else if (seg == 2) {
#pragma unroll
                for (int ai = 0; ai < 2; ++ai)
#pragma unroll
                    for (int m = 0; m < 4; ++m) { const size_t r = (size_t)(row0 + ai * HALF + m * 16);
#pragma unroll
                        for (int bj = 0; bj < 2; ++bj) st8(O + r * DM + hh * 256 + bj * HALF + ct, acc[ai][bj][m][0], acc[ai][bj][m][1]); }
            } else if (seg == 3) {
#pragma unroll
                for (int ai = 0; ai < 2; ++ai)
#pragma unroll
                    for (int m = 0; m < 4; ++m) { const size_t r = (size_t)(row0 + ai * HALF + m * 16);
#pragma unroll
                        for (int bj = 0; bj < 2; ++bj) { f32x4 v0 = acc[ai][bj][m][0], v1 = acc[ai][bj][m][1];
#pragma unroll
                            for (int e = 0; e < 4; ++e) { v0[e] = v0[e] * sigmoidf_(v0[e]); v1[e] = v1[e] * sigmoidf_(v1[e]); }
                            st8(O + r * DM + hh * 256 + bj * HALF + ct, v0, v1); } }
            } else {
                const int cb = hh * 256 + ct;
                f32x4 bv[2][2];
#pragma unroll
                for (int bj = 0; bj < 2; ++bj)
#pragma unroll
                    for (int n = 0; n < 2; ++n) bv[bj][n] = *(const f32x4*)(f0 + cb + bj * HALF + 4 * n);
#pragma unroll
                for (int ai = 0; ai < 2; ++ai)
#pragma unroll
                    for (int m = 0; m < 4; ++m) { const size_t r = (size_t)(row0 + ai * HALF + m * 16);
#pragma unroll
                        for (int bj = 0; bj < 2; ++bj) { f32x4 v0 = acc[ai][bj][m][0] + bv[bj][0], v1 = acc[ai][bj][m][1] + bv[bj][1];
#pragma unroll
                            for (int e = 0; e < 4; ++e) { v0[e] = sigmoidf_(v0[e]); v1[e] = sigmoidf_(v1[e]); }
                            st8(O + r * DM + cb + bj * HALF, v0, v1); } }
            }
        } else if constexpr (MODE == EM_RETO) {
            const int cb = u.pn * 256 + ct;
#pragma unroll
            for (int ai = 0; ai < 2; ++ai)
#pragma unroll
                for (int m = 0; m < 4; ++m) { const size_t r = (size_t)(row0 + ai * HALF + m * 16);
#pragma unroll
                    for (int bj = 0; bj < 2; ++bj) { f32x4 g0, g1, y0, y1; ld8(i0 + r * DM + cb + bj * HALF, g0, g1); ld8(i1 + r * DM + cb + bj * HALF, y0, y1);
                        st8(o[0] + r * DM + cb + bj * HALF, acc[ai][bj][m][0] * g0 + y0, acc[ai][bj][m][1] * g1 + y1); } }
        } else if constexpr (MODE == EM_MIXO) {
            const int cb = u.pn * 256 + ct;
            const int b = (u.pm * BM) / SEQ;
            f32x4 gv[2][2];
#pragma unroll
            for (int bj = 0; bj < 2; ++bj)
#pragma unroll
                for (int n = 0; n < 2; ++n) gv[bj][n] = *(const f32x4*)(f1 + (size_t)b * 6 * DM + cb + bj * HALF + 4 * n);
#pragma unroll
            for (int ai = 0; ai < 2; ++ai)
#pragma unroll
                for (int m = 0; m < 4; ++m) { const size_t r = (size_t)(row0 + ai * HALF + m * 16);
#pragma unroll
                    for (int bj = 0; bj < 2; ++bj) { const size_t off = r * DM + cb + bj * HALF;
                        st8(o[0] + off, *(const f32x4*)(f0 + off) + gv[bj][0] * acc[ai][bj][m][0], *(const f32x4*)(f0 + off + 4) + gv[bj][1] * acc[ai][bj][m][1]); } }
        } else if constexpr (MODE == EM_DOWN) {
            const int cb = u.pn * 256 + ct;
            const int b = (u.pm * BM) / SEQ;
            f32x4 gv[2][2];
#pragma unroll
            for (int bj = 0; bj < 2; ++bj)
#pragma unroll
                for (int n = 0; n < 2; ++n) gv[bj][n] = *(const f32x4*)(f1 + (size_t)b * 6 * DM + cb + bj * HALF + 4 * n);
#pragma unroll
            for (int ai = 0; ai < 2; ++ai)
#pragma unroll
                for (int m = 0; m < 4; ++m) { const size_t r = (size_t)(row0 + ai * HALF + m * 16);
#pragma unroll
                    for (int bj = 0; bj < 2; ++bj) { const size_t off = r * DM + cb + bj * HALF;
                        f32x4 d0, d1; ld8(i0 + off, d0, d1);
                        st8(o[0] + off, d0 + gv[bj][0] * acc[ai][bj][m][0], d1 + gv[bj][1] * acc[ai][bj][m][1]); } }
        } else if constexpr (MODE == EM_UG) {
            const int cb = u.pn * 128 + ct;
            f32x4 w0[2], w1[2], w2[2], bb[2];
#pragma unroll
            for (int n = 0; n < 2; ++n) { w0[n] = *(const f32x4*)(f0 + cb + 4 * n); w1[n] = *(const f32x4*)(f0 + DFF + cb + 4 * n); w2[n] = *(const f32x4*)(f0 + 2 * DFF + cb + 4 * n); bb[n] = *(const f32x4*)(f1 + cb + 4 * n); }
#pragma unroll
            for (int ai = 0; ai < 2; ++ai) {
                const int blk = (u.pm * BM + ai * HALF + wr * 64) >> 6;
                f32x4 p1[2], p2[2];
#pragma unroll
                for (int n = 0; n < 2; ++n) { p1[n] = (f32x4){0.f, 0.f, 0.f, 0.f}; p2[n] = p1[n]; }
#pragma unroll
                for (int m = 0; m < 4; ++m) { const size_t r = (size_t)(row0 + ai * HALF + m * 16);
                    f32x4 out[2];
#pragma unroll
                    for (int n = 0; n < 2; ++n) { const f32x4 g = acc[ai][1][m][n], upv = acc[ai][0][m][n]; f32x4 a1, a2;
#pragma unroll
                        for (int e = 0; e < 4; ++e) { a1[e] = __shfl(g[e], (fq << 4) | ((fr + 15) & 15)); a2[e] = __shfl(g[e], (fq << 4) | ((fr + 14) & 15)); }
#pragma unroll
                        for (int e = 0; e < 4; ++e) { const float pv1 = fr >= 1 ? a1[e] : p1[n][e], pv2 = fr >= 2 ? a2[e] : p2[n][e];
                            const float t = w0[n][e] * pv2 + w1[n][e] * pv1 + w2[n][e] * g[e] + bb[n][e]; out[n][e] = t * sigmoidf_(t) * upv[e]; }
                        p1[n] = a1; p2[n] = a2; }
                    st8(o[0] + r * DFF + cb, out[0], out[1]);
                    if (m == 0 && fr < 2) { st8(o[1] + (size_t)(blk * 2 + fr) * DFF + cb, acc[ai][1][0][0], acc[ai][1][0][1]); st8(o[2] + (size_t)(blk * 2 + fr) * DFF + cb, acc[ai][0][0][0], acc[ai][0][0][1]); }
                    if (m == 3 && fr >= 14) st8(o[3] + (size_t)(blk * 2 + fr - 14) * DFF + cb, acc[ai][1][3][0], acc[ai][1][3][1]); }
            }
        }
    }
};

template <class Epi, class Sched, bool ALIGN_EPI = false, bool SP2 = false>
__device__ __forceinline__ void gemm_phase(PG8_LAS unsigned char* lds, const Gemm g, const Sched& S, const Epi& E) {
    const int tid = threadIdx.x, wid = __builtin_amdgcn_readfirstlane(tid >> 6), lane = tid & 63, wr = wid >> 2, wc = wid & 3, fr = lane & 15, fq = lane >> 4;
    const int K = g.K, nt = K / BK;
    unsigned voffA[2], voffB[2];
#pragma unroll
    for (int i = 0; i < 2; ++i) { int R, C; stage_rc(tid * 16 + i * 8192, R, C); const int Rb = Epi::PERM ? ((R & ~31) + perm32(R & 31)) : R;
        voffA[i] = (unsigned)(R * K + C) * 2u; voffB[i] = (unsigned)(Rb * K + C) * 2u; }
    const size_t kstep = (size_t)(BK * 2);
    const size_t hstep = (size_t)HALF * K * 2;
    const size_t tstep = 2 * hstep;
    const unsigned ldsw = (unsigned)wid * 1024u;
    const int aoff = lds_byte(wr * 64 + fr, fq * 8), boff = lds_byte(wc * 32 + fr, fq * 8);
#define PG8_SA(b, h) (((b) * 2 + (h)) * HTB)
#define PG8_SB(b, h) ((4 + (b) * 2 + (h)) * HTB)
#define PG8_STAGE(bufoff, gbase, voff) do { _Pragma("unroll") for (int _i = 0; _i < 2; ++_i) \
        __builtin_amdgcn_global_load_lds((const unsigned*)((const char*)(gbase) + (voff)[_i]), (PG8_LAS unsigned*)(lds + (bufoff) + ldsw + _i * 8192), 16, 0, 0); } while (0)
#define PG8_LDA(dst, b, h) do { _Pragma("unroll") for (int m = 0; m < 4; ++m) _Pragma("unroll") for (int k = 0; k < 2; ++k) dst[m][k] = *(const PG8_LAS bf16x8*)(lds + PG8_SA(b, h) + aoff + m * 2048 + k * 1024); } while (0)
#define PG8_LDB(dst, b, h) do { _Pragma("unroll") for (int n = 0; n < 2; ++n) _Pragma("unroll") for (int k = 0; k < 2; ++k) dst[n][k] = *(const PG8_LAS bf16x8*)(lds + PG8_SB(b, h) + boff + n * 2048 + k * 1024); } while (0)
#define PG8_MMA(ai, bj, At, Bt) do { __builtin_amdgcn_s_setprio(1); _Pragma("unroll") for (int m = 0; m < 4; ++m) _Pragma("unroll") for (int n = 0; n < 2; ++n) _Pragma("unroll") for (int k = 0; k < 2; ++k) \
        acc[ai][bj][m][n] = __builtin_amdgcn_mfma_f32_16x16x32_bf16(Bt[n][k], At[m][k], acc[ai][bj][m][n], 0, 0, 0); __builtin_amdgcn_s_setprio(0); } while (0)
#define PG8_WAIT_V(n) asm volatile("s_waitcnt vmcnt(" #n ")" ::: "memory")
#define PG8_WAIT_L(n) asm volatile("s_waitcnt lgkmcnt(" #n ")" ::: "memory")
#define PG8_BAR __builtin_amdgcn_s_barrier()
#define PG8_SCHED __builtin_amdgcn_sched_barrier(0)
    Unit cur, nxt; int ui = 0;
    if (!S.next(0, cur)) return;
    f32x4 acc[2][2][4][2];
#pragma unroll
    for (int a = 0; a < 2; ++a)
#pragma unroll
        for (int b = 0; b < 2; ++b)
#pragma unroll
            for (int m = 0; m < 4; ++m)
#pragma unroll
                for (int n = 0; n < 2; ++n) acc[a][b][m][n] = (f32x4){0.f, 0.f, 0.f, 0.f};
    bf16x8 At[4][2], B0[2][2], B1[2][2];
    const char* cA = (const char*)g.A + (size_t)cur.pm * tstep; const char* cB = (const char*)g.Bt + (size_t)cur.pn * tstep;
    S.a_ready(cur);
    if constexpr (SP2) {
        PG8_STAGE(PG8_SB(0, 0), cB, voffB); PG8_STAGE(PG8_SB(0, 1), cB + hstep, voffB); PG8_STAGE(PG8_SA(0, 0), cA, voffA); PG8_STAGE(PG8_SA(0, 1), cA + hstep, voffA);
        if (wr == 1) PG8_BAR;
        PG8_WAIT_V(2); PG8_BAR;
        PG8_STAGE(PG8_SB(1, 0), cB + kstep, voffB); PG8_STAGE(PG8_SA(1, 0), cA + kstep, voffA); PG8_STAGE(PG8_SB(1, 1), cB + hstep + kstep, voffB);
        PG8_WAIT_V(6); PG8_BAR;
    } else {
        PG8_STAGE(PG8_SB(0, 0), cB, voffB); PG8_STAGE(PG8_SA(0, 0), cA, voffA); PG8_STAGE(PG8_SB(0, 1), cB + hstep, voffB); PG8_STAGE(PG8_SA(0, 1), cA + hstep, voffA);
        if (wr == 1) PG8_BAR;
        PG8_WAIT_V(4); PG8_BAR;
        PG8_STAGE(PG8_SB(1, 0), cB + kstep, voffB); PG8_STAGE(PG8_SA(1, 0), cA + kstep, voffA); PG8_STAGE(PG8_SB(1, 1), cB + hstep + kstep, voffB);
        PG8_WAIT_V(6); PG8_BAR;
    }
    for (;;) {
        const bool has_next = S.next(ui + 1, nxt);
        const char* nA = has_next ? (const char*)g.A + (size_t)nxt.pm * tstep : cA; const char* nB = has_next ? (const char*)g.Bt + (size_t)nxt.pn * tstep : cB;
        for (int t = 0; t < nt; t += 2) {
            const bool last = (t == nt - 2);
            const char* a1 = cA + (size_t)(t + 1) * kstep;
            const char* a2 = last ? nA : cA + (size_t)(t + 2) * kstep; const char* b2 = last ? nB : cB + (size_t)(t + 2) * kstep;
            const char* a3 = a2 + kstep; const char* b3 = b2 + kstep;
            if (last && has_next) S.a_ready(nxt);
            if constexpr (SP2) {
            PG8_LDB(B0, 0, 0); PG8_LDB(B1, 0, 1); PG8_SCHED; PG8_LDA(At, 0, 0); PG8_STAGE(PG8_SA(1, 1), a1 + hstep, voffA);
            PG8_WAIT_V(8); PG8_WAIT_L(0); PG8_BAR; PG8_MMA(0, 0, At, B0); PG8_MMA(0, 1, At, B1); PG8_BAR; PG8_SCHED;
            PG8_LDA(At, 0, 1); PG8_STAGE(PG8_SB(0, 0), b2, voffB); PG8_STAGE(PG8_SB(0, 1), b2 + hstep, voffB); PG8_STAGE(PG8_SA(0, 0), a2, voffA);
            PG8_WAIT_V(8); PG8_WAIT_L(0); PG8_BAR; PG8_MMA(1, 0, At, B0); PG8_MMA(1, 1, At, B1); PG8_BAR; PG8_SCHED;
            PG8_LDB(B0, 1, 0); PG8_LDB(B1, 1, 1); PG8_SCHED; PG8_LDA(At, 1, 0); PG8_STAGE(PG8_SA(0, 1), a2 + hstep, voffA);
            PG8_WAIT_V(8); PG8_WAIT_L(0); PG8_BAR; PG8_MMA(0, 0, At, B0); PG8_MMA(0, 1, At, B1); PG8_BAR; PG8_SCHED;
            PG8_LDA(At, 1, 1); PG8_STAGE(PG8_SB(1, 0), b3, voffB); PG8_STAGE(PG8_SB(1, 1), b3 + hstep, voffB); PG8_STAGE(PG8_SA(1, 0), a3, voffA);
            PG8_WAIT_V(8); PG8_WAIT_L(0); PG8_BAR; PG8_MMA(1, 0, At, B0); PG8_MMA(1, 1, At, B1); PG8_BAR; PG8_SCHED;
            } else {
            PG8_LDB(B0, 0, 0); PG8_SCHED; PG8_LDA(At, 0, 0); PG8_STAGE(PG8_SA(1, 1), a1 + hstep, voffA);
            PG8_WAIT_L(8); PG8_BAR; PG8_WAIT_L(0); PG8_MMA(0, 0, At, B0); PG8_BAR; PG8_SCHED;
            PG8_LDB(B1, 0, 1); PG8_STAGE(PG8_SB(0, 0), b2, voffB);
            PG8_BAR; PG8_WAIT_L(0); PG8_MMA(0, 1, At, B1); PG8_BAR;
            PG8_LDA(At, 0, 1); PG8_STAGE(PG8_SA(0, 0), a2, voffA);
            PG8_BAR; PG8_WAIT_L(0); PG8_MMA(1, 0, At, B0); PG8_BAR; PG8_SCHED;
            PG8_STAGE(PG8_SB(0, 1), b2 + hstep, voffB);
            PG8_WAIT_V(6); PG8_BAR; PG8_MMA(1, 1, At, B1); PG8_BAR;
            PG8_LDB(B0, 1, 0); PG8_SCHED; PG8_LDA(At, 1, 0); PG8_STAGE(PG8_SA(0, 1), a2 + hstep, voffA);
            PG8_WAIT_L(8); PG8_BAR; PG8_WAIT_L(0); PG8_MMA(0, 0, At, B0); PG8_BAR; PG8_SCHED;
            PG8_LDB(B1, 1, 1); PG8_STAGE(PG8_SB(1, 0), b3, voffB);
            PG8_BAR; PG8_WAIT_L(0); PG8_MMA(0, 1, At, B1); PG8_BAR;
            PG8_LDA(At, 1, 1); PG8_STAGE(PG8_SA(1, 0), a3, voffA);
            PG8_BAR; PG8_WAIT_L(0); PG8_MMA(1, 0, At, B0); PG8_BAR; PG8_SCHED;
            PG8_STAGE(PG8_SB(1, 1), b3 + hstep, voffB);
            PG8_WAIT_V(6); PG8_BAR; PG8_MMA(1, 1, At, B1); PG8_BAR;
            }
        }
        if constexpr (ALIGN_EPI) { if (wr == 0) PG8_BAR; }
        if constexpr (!Epi::AFTER_DRAIN) { E(acc, cur, wr, wc, fr, fq); S.done(cur); }
        if (!has_next) break;
#pragma unroll
        for (int a = 0; a < 2; ++a)
#pragma unroll
            for (int b = 0; b < 2; ++b)
#pragma unroll
                for (int m = 0; m < 4; ++m)
#pragma unroll
                    for (int n = 0; n < 2; ++n) acc[a][b][m][n] = (f32x4){0.f, 0.f, 0.f, 0.f};
        cur = nxt; cA = nA; cB = nB; ++ui;
        if constexpr (ALIGN_EPI) { if (wr == 1) PG8_BAR; }
    }
    PG8_WAIT_V(0);
    if constexpr (!ALIGN_EPI) { if (wr == 0) PG8_BAR; }
    PG8_BAR;
    if constexpr (Epi::AFTER_DRAIN) { E.fused(acc, cur, wr, wc, fr, fq, lds, wid, lane); S.done(cur); }
#undef PG8_SA
#undef PG8_SB
#undef PG8_STAGE
#undef PG8_LDA
#undef PG8_LDB
#undef PG8_MMA
#undef PG8_WAIT_V
#undef PG8_WAIT_L
#undef PG8_BAR
#undef PG8_SCHED
}
}

#define LAS __attribute__((address_space(3)))
typedef unsigned short bf16_t;
typedef short bf16x8 __attribute__((ext_vector_type(8)));
typedef short s16x4 __attribute__((ext_vector_type(4)));
typedef float f32x4 __attribute__((ext_vector_type(4)));
typedef unsigned u32x4 __attribute__((ext_vector_type(4)));
typedef unsigned u32x2 __attribute__((ext_vector_type(2)));
using pg8::cvt_pk_bf16; using pg8::bflo; using pg8::bfhi; using pg8::sigmoidf_;

constexpr int LDS_XB_OFF = 135168;
constexpr int LDS_BYTES = LDS_XB_OFF + 64;
constexpr size_t WS_XBAR = 896 * 1024;
constexpr size_t MiB = 1u << 20;
constexpr size_t WS_MOD = 0;
constexpr size_t WS_COS = 1 * MiB, WS_SIN = 9 * MiB;
constexpr size_t WS_WIN = 17 * MiB;
constexpr size_t WS_WRO = 89 * MiB, WS_WCO = 97 * MiB, WS_WMO = 105 * MiB;
constexpr size_t WS_S0 = 113 * MiB, WS_S1 = 177 * MiB, WS_S2 = 241 * MiB, WS_S3 = 305 * MiB, WS_S4 = 369 * MiB, WS_S5 = 433 * MiB, WS_S6 = 497 * MiB;
constexpr size_t WS_END = 561 * MiB;
constexpr size_t WS_WUG = 1 * MiB;
constexpr size_t WS_WDN = 45 * MiB;
constexpr size_t WS_XN2 = 67 * MiB, WS_UP = 131 * MiB, WS_GP = 307 * MiB;
constexpr size_t WS_H2 = 307 * MiB;
constexpr size_t WS_HEADG = 435 * MiB, WS_HEADU = 441 * MiB, WS_HALO = 447 * MiB;
constexpr size_t WS_CHEADP = WS_S2, WS_CHEADB = WS_S2 + 2 * MiB, WS_CHALOP = WS_S2 + 4 * MiB;

struct Args { const void* in[19]; float* out; unsigned char* ws; int lo, hi; };

__device__ __forceinline__ float wave_sum(float v) {
#pragma unroll
    for (int o = 1; o < 64; o <<= 1) v += __shfl_xor(v, o);
    return v;
}
#define LDS_WAIT() asm volatile("s_waitcnt lgkmcnt(0)" ::: "memory")

__device__ __forceinline__ void transpose_item(const float* __restrict__ W, int ldw, int k0, int c0, bf16_t* WT, int K, int r0, LAS float* scr, int lane) {
    float tv[32];
#pragma unroll
    for (int i = 0; i < 32; ++i) tv[i] = W[(size_t)(k0 + 2 * i + (lane >> 5)) * ldw + c0 + (lane & 31)];
#pragma unroll
    for (int i = 0; i < 32; ++i) scr[(2 * i + (lane >> 5)) * 33 + (lane & 31)] = tv[i];
    LDS_WAIT();
    const int c = lane & 7;
#pragma unroll
    for (int j = 0; j < 4; ++j) { const int n = (lane >> 3) + 8 * j; const LAS float* s = scr + (8 * c) * 33 + n;
        u32x4 o; o.x = cvt_pk_bf16(s[0 * 33], s[1 * 33]); o.y = cvt_pk_bf16(s[2 * 33], s[3 * 33]); o.z = cvt_pk_bf16(s[4 * 33], s[5 * 33]); o.w = cvt_pk_bf16(s[6 * 33], s[7 * 33]);
        *(u32x4*)(WT + (size_t)(r0 + n) * K + k0 + 8 * c) = o; }
    LDS_WAIT();
}

__device__ __forceinline__ int win_dst_row(int c) {
    const int seg = c >> 11, o = c & 2047;
    switch (seg) {
        case 0: return N_A + o;
        case 1: return N_A + 2048 + o;
        case 2: return N_A + 4096 + o;
        case 3: return N_A + 6144 + o;
        case 7: return N_A + 8192 + o;
        default: {
            const int bj = (seg == 6 || seg == 8) ? 1 : 0, n = (seg == 5 || seg == 8) ? 1 : 0, cl = o & 63;
            return (o >> 6) * 256 + bj * 128 + (cl >> 4) * 32 + ((cl >> 2) & 3) * 8 + n * 4 + (cl & 3); }
    }
}

__device__ __forceinline__ void transpose_item_win(const float* __restrict__ W, int k0, int c0, bf16_t* WT, LAS float* scr, int lane) {
    float tv[32];
#pragma unroll
    for (int i = 0; i < 32; ++i) tv[i] = W[(size_t)(k0 + 2 * i + (lane >> 5)) * 18432 + c0 + (lane & 31)];
#pragma unroll
    for (int i = 0; i < 32; ++i) scr[(2 * i + (lane >> 5)) * 33 + (lane & 31)] = tv[i];
    LDS_WAIT();
    const int c = lane & 7;
#pragma unroll
    for (int j = 0; j < 4; ++j) { const int n = (lane >> 3) + 8 * j; const LAS float* sp = scr + (8 * c) * 33 + n;
        u32x4 o; o.x = cvt_pk_bf16(sp[0 * 33], sp[1 * 33]); o.y = cvt_pk_bf16(sp[2 * 33], sp[3 * 33]); o.z = cvt_pk_bf16(sp[4 * 33], sp[5 * 33]); o.w = cvt_pk_bf16(sp[6 * 33], sp[7 * 33]);
        *(u32x4*)(WT + (size_t)win_dst_row(c0 + n) * DM + k0 + 8 * c) = o; }
    LDS_WAIT();
}

__device__ __forceinline__ void phase0(const Args& a, LAS unsigned char* lds, int G) {
    const int tid = threadIdx.x, lane = tid & 63, wave = tid >> 6, bid = blockIdx.x;
    unsigned char* ws = a.ws;
    {
        LAS float* scr = (LAS float*)(lds + 4096 + wave * 8704);
        const int gw = bid * 8 + wave, NGW = G * 8;
        constexpr int I_IN = 32 * 576, I_SQ = 32 * 64;
        constexpr int NIT = I_IN + 3 * I_SQ;
        bf16_t* Win = (bf16_t*)(ws + WS_WIN);
        for (int it = gw; it < NIT; it += NGW) {
            int r = it;
            if (r < I_IN) { const int kb = r / 576, nb = r % 576; transpose_item_win((const float*)a.in[7], kb * 64, nb * 32, Win, scr, lane); continue; } r -= I_IN;
            if (r < I_SQ) { const int kb = r / 64, nb = r % 64; transpose_item((const float*)a.in[10], DM, kb * 64, nb * 32, (bf16_t*)(ws + WS_WRO), DM, nb * 32, scr, lane); continue; } r -= I_SQ;
            if (r < I_SQ) { const int kb = r / 64, nb = r % 64; transpose_item((const float*)a.in[11], DM, kb * 64, nb * 32, (bf16_t*)(ws + WS_WCO), DM, nb * 32, scr, lane); continue; } r -= I_SQ;
            { const int kb = r / 64, nb = r % 64; transpose_item((const float*)a.in[12], DM, kb * 64, nb * 32, (bf16_t*)(ws + WS_WMO), DM, nb * 32, scr, lane); }
        }
    }
    {
        const int* pos = (const int*)a.in[2];
        float* ct = (float*)(ws + WS_COS); float* st = (float*)(ws + WS_SIN);
        for (int e = bid * 512 + tid; e < MTOK * 128; e += G * 512) {
            const int row = e >> 7, j = e & 127;
            const float inv = exp2f(-(float)j * 0.10381025296523008f);
            const float ang = (float)pos[row] * inv;
            const double t = (double)ang * 0.15915494309189535;
            const float fr = (float)(t - floor(t));
            ct[e] = __builtin_amdgcn_cosf(fr); st[e] = __builtin_amdgcn_sinf(fr);
        }
    }
}

__device__ __forceinline__ void ffn_weights_phase(const Args& a, LAS unsigned char* lds, int G) {
    const int lane = threadIdx.x & 63, wave = threadIdx.x >> 6;
    unsigned char* ws = a.ws;
    LAS float* scr = (LAS float*)(lds + 4096 + wave * 8704);
    const int gw = blockIdx.x * 8 + wave, NGW = G * 8;
    constexpr int I_FF = 32 * 176, I_DN = 88 * 64, NIT = 2 * I_FF + I_DN;
    for (int it = gw; it < NIT; it += NGW) {
        int r = it;
        if (r < I_FF) { const int kb = r / 176, nb = r % 176; transpose_item((const float*)a.in[13], DFF, kb * 64, nb * 32, (bf16_t*)(ws + WS_WUG), DM, (nb >> 2) * 256 + (nb & 3) * 32, scr, lane); continue; } r -= I_FF;
        if (r < I_FF) { const int kb = r / 176, nb = r % 176; transpose_item((const float*)a.in[14], DFF, kb * 64, nb * 32, (bf16_t*)(ws + WS_WUG), DM, (nb >> 2) * 256 + 128 + (nb & 3) * 32, scr, lane); continue; } r -= I_FF;
        { const int kb = r / 64, nb = r % 64; transpose_item((const float*)a.in[17], DM, kb * 64, nb * 32, (bf16_t*)(ws + WS_WDN), DFF, nb * 32, scr, lane); }
    }
}

__device__ __forceinline__ void adaln_phase(const Args& a, LAS unsigned char* lds, int G) {
    const int tid = threadIdx.x;
    const float* c = (const float*)a.in[1]; const float* Wada = (const float*)a.in[5]; const float* bada = (const float*)a.in[6];
    float* mod = (float*)(a.ws + WS_MOD);
    LAS float* cact = (LAS float*)lds;
    LAS f32x4* red = (LAS f32x4*)(lds + 65536);
    for (int i = tid; i < 8 * DM; i += 512) { const float v = c[i]; cact[i] = v * sigmoidf_(v); }
    __syncthreads();
    for (int cb = blockIdx.x; cb < 6 * DM / 48; cb += G) {
        const int cgl = tid % 12, kl = tid / 12;
        if (kl < 42) {
            f32x4 acc[8];
#pragma unroll
            for (int b = 0; b < 8; ++b) acc[b] = (f32x4){0.f, 0.f, 0.f, 0.f};
            const f32x4* wp = (const f32x4*)(Wada + cb * 48 + cgl * 4);
#pragma unroll 7
            for (int k = kl; k < DM; k += 42) { const f32x4 w = wp[(size_t)k * (6 * DM / 4)];
#pragma unroll
                for (int b = 0; b < 8; ++b) acc[b] += w * cact[b * DM + k]; }
#pragma unroll
            for (int b = 0; b < 8; ++b) red[(kl * 12 + cgl) * 8 + b] = acc[b];
        }
        __syncthreads();
        if (tid < 96) { const int cg2 = tid % 12, b = tid / 12;
            f32x4 s = *(const f32x4*)(bada + cb * 48 + cg2 * 4);
            for (int k = 0; k < 42; ++k) s += red[(k * 12 + cg2) * 8 + b];
            *(f32x4*)(mod + (size_t)b * (6 * DM) + cb * 48 + cg2 * 4) = s; }
        __syncthreads();
    }
}

template <bool HAS_DELTA> __device__ __forceinline__ void modnorm_phase(const float* src, const bf16_t* delta, const float* g, const float* mod_sh, const float* mod_sc, bf16_t* dst, int G) {
    const int lane = threadIdx.x & 63, gw = blockIdx.x * 8 + (threadIdx.x >> 6), NGW = G * 8;
    for (int r0 = gw; r0 < MTOK; r0 += 2 * NGW) {
        const bool has1 = r0 + NGW < MTOK; const int rr[2] = {r0, has1 ? r0 + NGW : r0};
        f32x4 v[2][8]; float ss[2] = {0.f, 0.f};
#pragma unroll
        for (int q = 0; q < 2; ++q)
#pragma unroll
            for (int j = 0; j < 8; ++j) {
                if constexpr (HAS_DELTA) { const u32x2 d = *((const u32x2*)(delta + (size_t)rr[q] * DM) + lane + 64 * j); v[q][j][0] = bflo(d.x); v[q][j][1] = bfhi(d.x); v[q][j][2] = bflo(d.y); v[q][j][3] = bfhi(d.y); }
                else v[q][j] = *((const f32x4*)(src + (size_t)rr[q] * DM) + lane + 64 * j); }
#pragma unroll
        for (int q = 0; q < 2; ++q)
#pragma unroll
            for (int j = 0; j < 8; ++j) ss[q] += (v[q][j][0] * v[q][j][0] + v[q][j][1] * v[q][j][1]) + (v[q][j][2] * v[q][j][2] + v[q][j][3] * v[q][j][3]);
        float rstd[2]; rstd[0] = rsqrtf(wave_sum(ss[0]) * (1.0f / DM) + EPS); rstd[1] = rsqrtf(wave_sum(ss[1]) * (1.0f / DM) + EPS);
#pragma unroll
        for (int q = 0; q < 2; ++q) { if (q == 1 && !has1) break;
            const int b = rr[q] >> 11; u32x2* o8 = (u32x2*)(dst + (size_t)rr[q] * DM) + lane;
#pragma unroll
            for (int j = 0; j < 8; ++j) { const int col = 4 * (lane + 64 * j);
                const f32x4 gg = *(const f32x4*)(g + col), sc = *(const f32x4*)(mod_sc + (size_t)b * 6 * DM + col), sh = *(const f32x4*)(mod_sh + (size_t)b * 6 * DM + col);
                const f32x4 y = v[q][j] * rstd[q] * gg * (sc + 1.0f) + sh;
                u32x2 w; w.x = cvt_pk_bf16(y[0], y[1]); w.y = cvt_pk_bf16(y[2], y[3]); o8[64 * j] = w; } }
    }
}

__device__ __forceinline__ void conv_fixup_phase(bf16_t* U, const bf16_t* HEADP, const bf16_t* HEADB, const bf16_t* HALOP, const float* wsc, int G) {
    constexpr int NCG = DM / 8;
    for (int idx = blockIdx.x * 512 + threadIdx.x; idx < (MTOK / 64) * 2 * NCG; idx += G * 512) {
        const int cgp = idx % NCG, br = idx / NCG, B = br >> 1, rr = br & 1, col = cgp * 8;
        const bool seqstart = ((B * 64) & (SEQ - 1)) == 0;
        const f32x4 z = {0.f, 0.f, 0.f, 0.f};
        f32x4 pa, pb, ba, bb, m1a = z, m1b = z, m2a = z, m2b = z;
        pg8::ld8(HEADP + (size_t)(B * 2 + rr) * DM + col, pa, pb); pg8::ld8(HEADB + (size_t)(B * 2 + rr) * DM + col, ba, bb);
        if (rr == 0) { if (!seqstart) { pg8::ld8(HALOP + (size_t)((B - 1) * 2 + 1) * DM + col, m1a, m1b); pg8::ld8(HALOP + (size_t)((B - 1) * 2) * DM + col, m2a, m2b); } }
        else { pg8::ld8(HEADP + (size_t)(B * 2) * DM + col, m1a, m1b); if (!seqstart) pg8::ld8(HALOP + (size_t)((B - 1) * 2 + 1) * DM + col, m2a, m2b); }
        const f32x4 w0a = *(const f32x4*)(wsc + col), w0b = *(const f32x4*)(wsc + col + 4), w1a = *(const f32x4*)(wsc + DM + col), w1b = *(const f32x4*)(wsc + DM + col + 4);
        const f32x4 w2a = *(const f32x4*)(wsc + 2 * DM + col), w2b = *(const f32x4*)(wsc + 2 * DM + col + 4);
        pg8::st8(U + (size_t)(B * 64 + rr) * DM + col, ba * (w0a * m2a + w1a * m1a + w2a * pa), bb * (w0b * m2b + w1b * m1b + w2b * pb));
    }
}

__device__ __forceinline__ void ffn_fixup_phase(bf16_t* ACT, const bf16_t* HEADG, const bf16_t* HEADU, const bf16_t* HALO, const float* wfc, const float* bfc, int G) {
    constexpr int NCG = DFF / 8;
    for (int idx = blockIdx.x * 512 + threadIdx.x; idx < (MTOK / 64) * 2 * NCG; idx += G * 512) {
        const int cgp = idx % NCG, br = idx / NCG, B = br >> 1, rr = br & 1, col = cgp * 8;
        const bool seqstart = ((B * 64) & (SEQ - 1)) == 0;
        const f32x4 z = {0.f, 0.f, 0.f, 0.f};
        f32x4 ga, gb, ua, ub, m1a = z, m1b = z, m2a = z, m2b = z;
        pg8::ld8(HEADG + (size_t)(B * 2 + rr) * DFF + col, ga, gb); pg8::ld8(HEADU + (size_t)(B * 2 + rr) * DFF + col, ua, ub);
        if (rr == 0) { if (!seqstart) { pg8::ld8(HALO + (size_t)((B - 1) * 2 + 1) * DFF + col, m1a, m1b); pg8::ld8(HALO + (size_t)((B - 1) * 2) * DFF + col, m2a, m2b); } }
        else { pg8::ld8(HEADG + (size_t)(B * 2) * DFF + col, m1a, m1b); if (!seqstart) pg8::ld8(HALO + (size_t)((B - 1) * 2 + 1) * DFF + col, m2a, m2b); }
        const f32x4 w0a = *(const f32x4*)(wfc + col), w0b = *(const f32x4*)(wfc + col + 4), w1a = *(const f32x4*)(wfc + DFF + col), w1b = *(const f32x4*)(wfc + DFF + col + 4);
        const f32x4 w2a = *(const f32x4*)(wfc + 2 * DFF + col), w2b = *(const f32x4*)(wfc + 2 * DFF + col + 4), ba = *(const f32x4*)(bfc + col), bb = *(const f32x4*)(bfc + col + 4);
        f32x4 ta = w0a * m2a + w1a * m1a + w2a * ga + ba, tb = w0b * m2b + w1b * m1b + w2b * gb + bb;
#pragma unroll
        for (int e = 0; e < 4; ++e) { ta[e] = ta[e] * sigmoidf_(ta[e]); tb[e] = tb[e] * sigmoidf_(tb[e]); }
        pg8::st8(ACT + (size_t)(B * 64 + rr) * DFF + col, ta * ua, tb * ub);
    }
}

__device__ __forceinline__ void retnorm_phase(bf16_t* Y, const bf16_t* SG, int G) {
    const int lane = threadIdx.x & 63, gw = blockIdx.x * 8 + (threadIdx.x >> 6), NGW = G * 8;
    for (int r0 = gw; r0 < MTOK; r0 += 2 * NGW) {
        const bool has1 = r0 + NGW < MTOK; const int rr[2] = {r0, has1 ? r0 + NGW : r0};
        f32x4 ya[2][4], yb[2][4], ga[2][4], gb[2][4];
#pragma unroll
        for (int q = 0; q < 2; ++q)
#pragma unroll
            for (int c = 0; c < 4; ++c) { const size_t off = (size_t)rr[q] * DM + c * 512 + lane * 8; pg8::ld8(Y + off, ya[q][c], yb[q][c]); pg8::ld8(SG + off, ga[q][c], gb[q][c]); }
#pragma unroll
        for (int q = 0; q < 2; ++q) { if (q == 1 && !has1) break;
#pragma unroll
            for (int c = 0; c < 4; ++c) { const size_t off = (size_t)rr[q] * DM + c * 512 + lane * 8; const f32x4 a = ya[q][c], b = yb[q][c];
                float ss = (a[0] * a[0] + a[1] * a[1]) + (a[2] * a[2] + a[3] * a[3]) + (b[0] * b[0] + b[1] * b[1]) + (b[2] * b[2] + b[3] * b[3]);
#pragma unroll
                for (int o = 1; o < 32; o <<= 1) ss += __shfl_xor(ss, o);
                const float rstd = rsqrtf(ss * (1.0f / 256.0f) + EPS);
                pg8::st8(Y + off, a * rstd * ga[q][c], b * rstd * gb[q][c]); } }
    }
}

__device__ __forceinline__ void final_norm_phase(const bf16_t* H, float* O, const float* g, int G) {
    const int lane = threadIdx.x & 63, gw = blockIdx.x * 8 + (threadIdx.x >> 6), NGW = G * 8;
    for (int r0 = gw; r0 < MTOK; r0 += 2 * NGW) {
        const bool has1 = r0 + NGW < MTOK; const int rr[2] = {r0, has1 ? r0 + NGW : r0};
        u32x2 d[2][8];
#pragma unroll
        for (int q = 0; q < 2; ++q)
#pragma unroll
            for (int j = 0; j < 8; ++j) d[q][j] = *((const u32x2*)(H + (size_t)rr[q] * DM) + lane + 64 * j);
#pragma unroll
        for (int q = 0; q < 2; ++q) { if (q == 1 && !has1) break;
            f32x4 v[8]; float ss = 0.f;
#pragma unroll
            for (int j = 0; j < 8; ++j) { v[j][0] = bflo(d[q][j].x); v[j][1] = bfhi(d[q][j].x); v[j][2] = bflo(d[q][j].y); v[j][3] = bfhi(d[q][j].y); ss += (v[j][0] * v[j][0] + v[j][1] * v[j][1]) + (v[j][2] * v[j][2] + v[j][3] * v[j][3]); }
            const float rstd = rsqrtf(wave_sum(ss) * (1.0f / DM) + EPS);
            f32x4* orow = (f32x4*)(O + (size_t)rr[q] * DM) + lane;
#pragma unroll
            for (int j = 0; j < 8; ++j) { const f32x4 gg = *(const f32x4*)(g + 4 * (lane + 64 * j)); orow[64 * j] = v[j] * rstd * gg; } }
    }
}

constexpr int RS_Q = 560, RS_V = 144;
constexpr int OFF_Q = 0, OFF_K = 64 * RS_Q, OFF_ST = 2 * 64 * RS_Q, OFF_V = 3 * 64 * RS_Q, OFF_P = OFF_V + 64 * RS_V, OFF_V2 = OFF_P + 64 * RS_V;
__device__ __forceinline__ bf16x8 tr8(const LAS unsigned char* p, int stride4) {
    const s16x4 x = __builtin_amdgcn_ds_read_tr16_b64_v4i16((LAS s16x4*)p);
    const s16x4 y = __builtin_amdgcn_ds_read_tr16_b64_v4i16((LAS s16x4*)(p + stride4));
    return (bf16x8){x[0], x[1], x[2], x[3], y[0], y[1], y[2], y[3]};
}
__device__ __forceinline__ f32x4 mfma_k(bf16x8 a, bf16x8 b, f32x4 c) {
    const f32x4 d = __builtin_amdgcn_mfma_f32_16x16x32_bf16(a, b, c, 0, 0, 0);
    asm volatile("" :: "v"(a), "v"(b));
    return d;
}
__device__ __forceinline__ void retention_unit(LAS unsigned char* lds, const bf16_t* Qg, const bf16_t* Kg, const bf16_t* Vg, bf16_t* Yg, int bh, int es) {
    const int tid = threadIdx.x, lane = tid & 63, w = __builtin_amdgcn_readfirstlane(tid >> 6), fr = lane & 15, fq = lane >> 4;
    const int b = bh >> 3, h = bh & 7;
    const float gam = 1.0f - exp2f(-5.0f - (float)h), lg = log2f(gam);
    const size_t base = (size_t)b * SEQ * DM + h * 256;
    const bf16_t* qp = Qg + base; const bf16_t* kp = Kg + base; const bf16_t* vp = Vg + base + es * 64; bf16_t* yp = Yg + base + es * 64;
    const int vrow = tid >> 3, vch = tid & 7;
    const float vsc = exp2f(lg * (float)(63 - vrow));
    const float sdec = exp2f(lg * 64.0f);
    const int it_s = w >> 1, jt0 = (w & 1) * 2;
    const int et = w & 3, itp = (w >> 2) * 2;
    const float pscale = exp2f(lg * (float)(it_s * 16 + fr - 63));
    float ysc[2]; ysc[0] = exp2f(lg * (float)(itp * 16 + fr + 1)); ysc[1] = exp2f(lg * (float)(itp * 16 + 16 + fr + 1));
    const int ql = (lane & 15) >> 2, pl = lane & 3;
    f32x4 sacc[2][4];
#pragma unroll
    for (int d = 0; d < 2; ++d)
#pragma unroll
        for (int e = 0; e < 4; ++e) sacc[d][e] = (f32x4){0.f, 0.f, 0.f, 0.f};
    u32x4 qr[4], kr[4], vr;
#define RET_STAGE(vb) do { _Pragma("unroll") for (int i = 0; i < 4; ++i) { const int p = tid + 512 * i, row = p >> 5, ch = p & 31; \
            *(LAS u32x4*)(lds + OFF_Q + row * RS_Q + ch * 16) = qr[i]; *(LAS u32x4*)(lds + OFF_K + row * RS_Q + ch * 16) = kr[i]; } \
        { u32x4 o; o.x = cvt_pk_bf16(bflo(vr.x) * vsc, bfhi(vr.x) * vsc); o.y = cvt_pk_bf16(bflo(vr.y) * vsc, bfhi(vr.y) * vsc); \
          o.z = cvt_pk_bf16(bflo(vr.z) * vsc, bfhi(vr.z) * vsc); o.w = cvt_pk_bf16(bflo(vr.w) * vsc, bfhi(vr.w) * vsc); \
          *(LAS u32x4*)(lds + ((vb) ? OFF_V2 : OFF_V) + vrow * RS_V + vch * 16) = o; } } while (0)
#define RET_LOAD(c) do { const size_t ro = (size_t)(c) * 64 * DM; _Pragma("unroll") for (int i = 0; i < 4; ++i) { const int p = tid + 512 * i, row = p >> 5, ch = p & 31; \
            qr[i] = *(const u32x4*)(qp + ro + (size_t)row * DM + ch * 8); kr[i] = *(const u32x4*)(kp + ro + (size_t)row * DM + ch * 8); } \
        vr = *(const u32x4*)(vp + ro + (size_t)vrow * DM + vch * 8); } while (0)
    __syncthreads();
    for (int i = tid; i < (64 * RS_Q) / 16; i += 512) *(LAS u32x4*)(lds + OFF_ST + i * 16) = (u32x4){0u, 0u, 0u, 0u};
    RET_LOAD(0);
    RET_STAGE(0);
    __syncthreads();
    for (int c = 0; c < SEQ / 64; ++c) {
        const int vb = c & 1;
        const LAS unsigned char* vcur = lds + (vb ? OFF_V2 : OFF_V);
        if (c + 1 < SEQ / 64) RET_LOAD(c + 1);
        {
            f32x4 sa[2] = {{0.f, 0.f, 0.f, 0.f}, {0.f, 0.f, 0.f, 0.f}};
            if (jt0 <= it_s) {
#pragma unroll
                for (int kk = 0; kk < 8; ++kk) {
                    const bf16x8 bq = *(const LAS bf16x8*)(lds + OFF_Q + (it_s * 16 + fr) * RS_Q + kk * 64 + fq * 16);
                    const bf16x8 a0 = *(const LAS bf16x8*)(lds + OFF_K + (jt0 * 16 + fr) * RS_Q + kk * 64 + fq * 16);
                    const bf16x8 a1 = *(const LAS bf16x8*)(lds + OFF_K + (jt0 * 16 + 16 + fr) * RS_Q + kk * 64 + fq * 16);
                    sa[0] = mfma_k(a0, bq, sa[0]);
                    sa[1] = mfma_k(a1, bq, sa[1]);
                }
            }
            const int i = it_s * 16 + fr;
#pragma unroll
            for (int t = 0; t < 2; ++t) { const int j0 = (jt0 + t) * 16 + 4 * fq;
                float p0 = (i >= j0) ? sa[t][0] * pscale : 0.f, p1 = (i >= j0 + 1) ? sa[t][1] * pscale : 0.f, p2 = (i >= j0 + 2) ? sa[t][2] * pscale : 0.f, p3 = (i >= j0 + 3) ? sa[t][3] * pscale : 0.f;
                u32x2 o; o.x = cvt_pk_bf16(p0, p1); o.y = cvt_pk_bf16(p2, p3);
                *(LAS u32x2*)(lds + OFF_P + i * RS_V + j0 * 2) = o; }
        }
        f32x4 ya[2] = {{0.f, 0.f, 0.f, 0.f}, {0.f, 0.f, 0.f, 0.f}};
#pragma unroll
        for (int kk = 0; kk < 8; ++kk) {
            const bf16x8 as = *(const LAS bf16x8*)(lds + OFF_ST + (et * 16 + fr) * RS_Q + kk * 64 + fq * 16);
            const bf16x8 b0 = *(const LAS bf16x8*)(lds + OFF_Q + (itp * 16 + fr) * RS_Q + kk * 64 + fq * 16);
            const bf16x8 b1 = *(const LAS bf16x8*)(lds + OFF_Q + (itp * 16 + 16 + fr) * RS_Q + kk * 64 + fq * 16);
            ya[0] = mfma_k(as, b0, ya[0]);
            ya[1] = mfma_k(as, b1, ya[1]);
        }
        ya[0] *= ysc[0]; ya[1] *= ysc[1];
#pragma unroll
        for (int d = 0; d < 2; ++d)
#pragma unroll
            for (int e = 0; e < 4; ++e) sacc[d][e] *= sdec;
#pragma unroll
        for (int kk = 0; kk < 2; ++kk) {
            bf16x8 ak[2], bv[4];
#pragma unroll
            for (int d = 0; d < 2; ++d) ak[d] = tr8(lds + OFF_K + (kk * 32 + 8 * fq + ql) * RS_Q + ((2 * w + d) * 16 + 4 * pl) * 2, 4 * RS_Q);
#pragma unroll
            for (int e = 0; e < 4; ++e) bv[e] = tr8(vcur + (kk * 32 + 8 * fq + ql) * RS_V + (e * 16 + 4 * pl) * 2, 4 * RS_V);
#pragma unroll
            for (int d = 0; d < 2; ++d)
#pragma unroll
                for (int e = 0; e < 4; ++e) sacc[d][e] = mfma_k(ak[d], bv[e], sacc[d][e]);
        }
        __syncthreads();
#pragma unroll
        for (int d = 0; d < 2; ++d)
#pragma unroll
            for (int e = 0; e < 4; ++e) { u32x2 o; o.x = cvt_pk_bf16(sacc[d][e][0], sacc[d][e][1]); o.y = cvt_pk_bf16(sacc[d][e][2], sacc[d][e][3]);
                *(LAS u32x2*)(lds + OFF_ST + (e * 16 + fr) * RS_Q + ((2 * w + d) * 16 + 4 * fq) * 2) = o; }
        if (c + 1 < SEQ / 64) { if (vb) RET_STAGE(0); else RET_STAGE(1); }
#pragma unroll
        for (int kk = 0; kk < 2; ++kk) {
            const bf16x8 av = tr8(vcur + (kk * 32 + 8 * fq + ql) * RS_V + (et * 16 + 4 * pl) * 2, 4 * RS_V);
            const bf16x8 b0 = *(const LAS bf16x8*)(lds + OFF_P + (itp * 16 + fr) * RS_V + kk * 64 + fq * 16);
            const bf16x8 b1 = *(const LAS bf16x8*)(lds + OFF_P + (itp * 16 + 16 + fr) * RS_V + kk * 64 + fq * 16);
            ya[0] = mfma_k(av, b0, ya[0]);
            ya[1] = mfma_k(av, b1, ya[1]);
        }
#pragma unroll
        for (int t = 0; t < 2; ++t) { u32x2 o; o.x = cvt_pk_bf16(ya[t][0], ya[t][1]); o.y = cvt_pk_bf16(ya[t][2], ya[t][3]);
            *(u32x2*)(yp + (size_t)(c * 64 + (itp + t) * 16 + fr) * DM + et * 16 + 4 * fq) = o; }
        __syncthreads();
    }
#undef RET_STAGE
#undef RET_LOAD
}
__device__ __forceinline__ void retention_phase(LAS unsigned char* lds, const bf16_t* Q, const bf16_t* K, const bf16_t* V, bf16_t* Y, int G, int vc) {
    for (int u0 = vc; u0 < 256; u0 += G) {
        const int u = (G == 256) ? ((u0 & 7) * 32 + (u0 >> 3)) : u0;
        retention_unit(lds, Q, K, V, Y, u >> 2, u & 3);
    }
}

#define XB_TMO      128
#define XB_XCNT(j)  (256  + 64 * (j))
#define XB_XSUB(j)  (1280 + 64 * (j))
#define XB_XGEN(j)  (2304 + 64 * (j))
#define XB_TOP      3328
#define XB_TOPGEN   3392
#define XCD_BAR_WORDS 3456
#define XB_SPIN_CAP (1u << 18)

__device__ __forceinline__ unsigned xb_ld(unsigned* p)              { return __hip_atomic_load(p, __ATOMIC_RELAXED, __HIP_MEMORY_SCOPE_AGENT); }
__device__ __forceinline__ unsigned xb_add(unsigned* p, unsigned v) { return __hip_atomic_fetch_add(p, v, __ATOMIC_RELAXED, __HIP_MEMORY_SCOPE_AGENT); }
__device__ __forceinline__ unsigned xb_xcc_id() { return (unsigned)__builtin_amdgcn_s_getreg((3 << 11) | 20) & 0xFu; }
#define XB_SPIN(cond, bar) do { unsigned _sp = 0; while (cond) { __builtin_amdgcn_s_sleep(1); \
    if ((++_sp & 255u) == 0u) { if (xb_ld(&(bar)[XB_TMO])) break; if (_sp > XB_SPIN_CAP) { atomicAdd(&(bar)[XB_TMO], 1u); break; } } } } while (0)

struct XcdBarrier {
    unsigned* bar; unsigned x;
    volatile LAS unsigned* st;
};

__device__ __forceinline__ XcdBarrier xcd_barrier_post(unsigned* bar, volatile LAS unsigned* st) {
    XcdBarrier b; b.bar = bar; b.x = xb_xcc_id(); b.st = st;
    if (threadIdx.x == 0) { st[2] = xb_add(&bar[XB_XCNT(b.x)], 1u); st[3] = b.x; }
    return b;
}
__device__ __forceinline__ void xcd_barrier_complete(unsigned* bar, unsigned x, unsigned& nloc, unsigned& nx) {
    const unsigned G = gridDim.x * gridDim.y * gridDim.z;
    unsigned sum, cnt, mine, sp = 0u;
    for (;;) {
        sum = 0u; cnt = 0u; mine = 0u;
#pragma unroll
        for (unsigned j = 0; j < 16; ++j) { const unsigned c = xb_ld(&bar[XB_XCNT(j)]); sum += c; cnt += (c > 0u) ? 1u : 0u; mine = (j == x) ? c : mine; }
        if (sum == G) break;
        __builtin_amdgcn_s_sleep(1);
        if ((++sp & 255u) == 0u) { if (xb_ld(&bar[XB_TMO])) break; if (sp > XB_SPIN_CAP) { atomicAdd(&bar[XB_TMO], 1u); break; } }
    }
    nloc = mine > 0u ? mine : 1u; nx = cnt > 0u ? cnt : 1u;
}

__device__ __forceinline__ void xcd_barrier(const XcdBarrier& b) {
    asm volatile("s_waitcnt vmcnt(0)" ::: "memory");
    __syncthreads();
    if (threadIdx.x == 0) {
        unsigned* bar = b.bar;
        __builtin_amdgcn_s_waitcnt(0);
        unsigned nloc = b.st[0], nx = b.st[1];
        if (nloc == 0u) { xcd_barrier_complete(bar, b.x, nloc, nx); b.st[0] = nloc; b.st[1] = nx; }
        const unsigned old = xb_add(&bar[XB_XSUB(b.x)], 1u);
        const unsigned gen = old / nloc;
        if (old + 1u == (gen + 1u) * nloc) {
            __builtin_amdgcn_fence(__ATOMIC_RELEASE, "agent");
            asm volatile("s_waitcnt vmcnt(0)" ::: "memory");
            const unsigned og = xb_add(&bar[XB_TOP], 1u);
            const unsigned tg = og / nx;
            if (og + 1u == (tg + 1u) * nx) xb_add(&bar[XB_TOPGEN], 1u);
            else XB_SPIN(xb_ld(&bar[XB_TOPGEN]) == tg, bar);
            __builtin_amdgcn_fence(__ATOMIC_ACQUIRE, "agent");
            xb_add(&bar[XB_XGEN(b.x)], 1u);
            asm volatile("s_waitcnt vmcnt(0)" ::: "memory");
        } else {
            XB_SPIN(xb_ld(&bar[XB_XGEN(b.x)]) == gen, bar);
            __builtin_amdgcn_fence(__ATOMIC_ACQUIRE, "agent");
            asm volatile("s_waitcnt vmcnt(0)" ::: "memory");
        }
    }
    __syncthreads();
}


template <int MODE> __device__ __forceinline__ void run_gemm(LAS unsigned char* lds, const bf16_t* A, const bf16_t* Bt, int N, int K, const pg8::Epi<MODE>& E, int G, int vc) {
    pg8::Gemm g{A, Bt, MTOK, N, K}; pg8::StaticOrder S; S.init(MTOK, N, G, vc);
    pg8::gemm_phase<pg8::Epi<MODE>, pg8::StaticOrder, true, true>(lds, g, S, E);
}

__global__ void __launch_bounds__(512, 2) fwd_megakernel(Args a) {
    extern __shared__ __attribute__((aligned(16))) unsigned char lds_raw[];
    LAS unsigned char* lds = (LAS unsigned char*)lds_raw;
    cg::grid_group grid = cg::this_grid();
    const int G = gridDim.x, lo = a.lo, hi = a.hi;
    unsigned char* ws = a.ws;
    float* mod = (float*)(ws + WS_MOD);
    bf16_t* S0 = (bf16_t*)(ws + WS_S0); bf16_t* S1 = (bf16_t*)(ws + WS_S1); bf16_t* S2 = (bf16_t*)(ws + WS_S2); bf16_t* S3 = (bf16_t*)(ws + WS_S3);
    bf16_t* S4 = (bf16_t*)(ws + WS_S4); bf16_t* S5 = (bf16_t*)(ws + WS_S5); bf16_t* S6 = (bf16_t*)(ws + WS_S6);
    const float* x = (const float*)a.in[0];
#define IN(k) (lo <= (k) && (k) < hi)
#define GSYNC() xcd_barrier(xbar)
#define SEAM(k) do { if ((k) + 1 < hi) GSYNC(); } while (0)

    if (threadIdx.x < 16) ((LAS unsigned*)(lds + LDS_XB_OFF))[threadIdx.x] = 0u;
    __syncthreads();
    const XcdBarrier xbar = xcd_barrier_post((unsigned*)(ws + WS_XBAR), (volatile LAS unsigned*)(lds + LDS_XB_OFF));
    if (hi < 0) grid.sync();
    if (IN(0)) { adaln_phase(a, lds, G); SEAM(0); }
    int vc = (int)blockIdx.x;
    if (lo == 0 && hi > 1) {
        volatile LAS unsigned* stw = (volatile LAS unsigned*)(lds + LDS_XB_OFF);
        if (threadIdx.x == 0) { bool even = (G % 8 == 0);
            for (unsigned j = 0; j < 16; ++j) { const unsigned cnt = xb_ld((unsigned*)(ws + WS_XBAR) + XB_XCNT(j)); even = even && (cnt == (j < 8 ? (unsigned)G / 8u : 0u)); }
            stw[4] = even ? (stw[3] + 8u * stw[2]) : (unsigned)blockIdx.x; }
        __syncthreads();
        vc = __builtin_amdgcn_readfirstlane((int)stw[4]);
    }
    if (IN(2)) { phase0(a, lds, G); modnorm_phase<false>(x, nullptr, (const float*)a.in[3], mod + 0 * DM, mod + 1 * DM, S0, G); SEAM(2); }
    if (IN(3)) {
        pg8::Epi<pg8::EM_A> E{}; E.o[0] = S1; E.o[1] = (bf16_t*)(ws + WS_CHEADP); E.o[2] = S3; E.o[3] = (bf16_t*)(ws + WS_CHEADB); E.o[4] = (bf16_t*)(ws + WS_CHALOP); E.f0 = (const float*)a.in[8]; E.f1 = (const float*)a.in[9];
        run_gemm<pg8::EM_A>(lds, S0, (const bf16_t*)(ws + WS_WIN), N_A, DM, E, G, vc); SEAM(3); }
    if (IN(4)) { conv_fixup_phase(S1, (const bf16_t*)(ws + WS_CHEADP), (const bf16_t*)(ws + WS_CHEADB), (const bf16_t*)(ws + WS_CHALOP), (const float*)a.in[9], G); SEAM(4); }
    if (IN(5)) {
        pg8::Epi<pg8::EM_CONVO> E{}; E.o[0] = S4; E.i0 = S3;
        run_gemm<pg8::EM_CONVO>(lds, S1, (const bf16_t*)(ws + WS_WCO), DM, DM, E, G, vc); SEAM(5); }
    if (IN(6)) {
        pg8::Epi<pg8::EM_D> E{}; E.o[0] = S1; E.o[1] = S2; E.o[2] = S3; E.o[3] = S5; E.o[4] = S6;
        E.f0 = (const float*)a.in[8]; E.f1 = (const float*)(ws + WS_COS); E.f2 = (const float*)(ws + WS_SIN);
        run_gemm<pg8::EM_D>(lds, S0, (const bf16_t*)(ws + WS_WIN) + (size_t)N_A * DM, N_D, DM, E, G, vc); SEAM(6); }
    if (IN(7)) { retention_phase(lds, S1, S2, S3, S0, G, vc); SEAM(7); }
    if (IN(8)) { retnorm_phase(S0, S5, G); SEAM(8); }
    if (IN(9)) {
        pg8::Epi<pg8::EM_RETO> E{}; E.o[0] = S1; E.i0 = S6; E.i1 = S4;
        run_gemm<pg8::EM_RETO>(lds, S0, (const bf16_t*)(ws + WS_WRO), DM, DM, E, G, vc); SEAM(9); }
    if (IN(10)) {
        pg8::Epi<pg8::EM_MIXO> E{}; E.o[0] = S6; E.f0 = x; E.f1 = mod + 2 * DM;
        run_gemm<pg8::EM_MIXO>(lds, S1, (const bf16_t*)(ws + WS_WMO), DM, DM, E, G, vc); SEAM(10); }
    if (IN(11)) {
        modnorm_phase<true>(x, S6, (const float*)a.in[4], mod + 3 * DM, mod + 4 * DM, (bf16_t*)(ws + WS_XN2), G);
        ffn_weights_phase(a, lds, G); SEAM(11); }
    if (IN(12)) {
        pg8::Epi<pg8::EM_UG> E{}; E.o[0] = (bf16_t*)(ws + WS_UP); E.o[1] = (bf16_t*)(ws + WS_HEADG); E.o[2] = (bf16_t*)(ws + WS_HEADU); E.o[3] = (bf16_t*)(ws + WS_HALO); E.f0 = (const float*)a.in[15]; E.f1 = (const float*)a.in[16];
        run_gemm<pg8::EM_UG>(lds, (const bf16_t*)(ws + WS_XN2), (const bf16_t*)(ws + WS_WUG), N_UG, DM, E, G, vc); SEAM(12); }
    if (IN(13)) { ffn_fixup_phase((bf16_t*)(ws + WS_UP), (const bf16_t*)(ws + WS_HEADG), (const bf16_t*)(ws + WS_HEADU), (const bf16_t*)(ws + WS_HALO), (const float*)a.in[15], (const float*)a.in[16], G); SEAM(13); }
    if (IN(14)) {
        pg8::Epi<pg8::EM_DOWN> E{}; E.o[0] = (bf16_t*)(ws + WS_H2); E.i0 = S6; E.f1 = mod + 5 * DM;
        run_gemm<pg8::EM_DOWN>(lds, (const bf16_t*)(ws + WS_UP), (const bf16_t*)(ws + WS_WDN), DM, DFF, E, G, vc); SEAM(14); }
    if (IN(15)) { final_norm_phase((const bf16_t*)(ws + WS_H2), a.out, (const float*)a.in[18], G); }
}

extern "C" void kernel_launch(void* const* d_in, const int* in_sizes, int n_in, void* d_out, int out_size, void* d_ws, size_t ws_size, hipStream_t stream) {
    static int grid = 0;
    if (grid == 0) {
        if (n_in != 19 || out_size != MTOK * DM || ws_size < WS_END) { fprintf(stderr, "kernel_launch: unexpected shapes (n_in %d out %d ws %zu, need %zu)\n", n_in, out_size, ws_size, (size_t)WS_END); grid = -1; return; }
        int dev = 0, cus = 0, per_cu = 0;
        (void)hipGetDevice(&dev); (void)hipDeviceGetAttribute(&cus, hipDeviceAttributeMultiprocessorCount, dev);
        (void)hipFuncSetAttribute((const void*)fwd_megakernel, hipFuncAttributeMaxDynamicSharedMemorySize, LDS_BYTES);
        (void)hipOccupancyMaxActiveBlocksPerMultiprocessor(&per_cu, fwd_megakernel, 512, LDS_BYTES);
        if (per_cu < 1) { fprintf(stderr, "kernel_launch: occupancy query says %d blocks/CU\n", per_cu); per_cu = 1; }
        grid = cus;
    }
    if (grid < 0) return;
    Args a{};
    for (int i = 0; i < 19; ++i) a.in[i] = d_in[i];
    a.out = (float*)d_out; a.ws = (unsigned char*)d_ws;
#if MK_N_LAUNCHES == 1
    a.lo = 0; a.hi = NPHASE;
    void* params[] = {&a};
    (void)hipMemsetAsync((unsigned char*)d_ws + WS_XBAR, 0, 16384, stream);
    hipError_t e = hipLaunchCooperativeKernel((const void*)fwd_megakernel, dim3(grid), dim3(512), params, LDS_BYTES, stream);
    if (e != hipSuccess) fprintf(stderr, "cooperative launch failed: %s (grid %d)\n", hipGetErrorString(e), grid);
#else
    for (int p = 0; p < NPHASE; ++p) { a.lo = p; a.hi = p + 1; hipLaunchKernelGGL(fwd_megakernel, dim3(grid), dim3(512), LDS_BYTES, stream, a); }
#endif
}
```

```cpp
#include <hip/hip_runtime.h>
#include <hip/hip_cooperative_groups.h>
#include <cstdio>
#include <cstdint>
namespace cg = cooperative_groups;

#ifndef MK_N_LAUNCHES
#define MK_N_LAUNCHES 1
#endif

constexpr int DM = 2048, NBATCH = 8, SEQ = 2048, MTOK = NBATCH * SEQ, DFF = 5632, NHEAD = 8;
constexpr int N_A = 8192, N_D = 10240, N_UG = 2 * DFF;
constexpr float EPS = 1e-6f;
constexpr int NPHASE = 16;

namespace pg8 {
#define PG8_LAS __attribute__((address_space(3)))
typedef unsigned short bf16_t;
typedef short bf16x8 __attribute__((ext_vector_type(8)));
typedef float f32x4 __attribute__((ext_vector_type(4)));
typedef unsigned u32x4 __attribute__((ext_vector_type(4)));
constexpr int BM = 256, BK = 64, HALF = 128, HTB = HALF * BK * 2  , STAGE_BYTES = 8 * HTB, NXCD = 8, WGM = 8;

__host__ __device__ __forceinline__ int lds_byte(int r, int c) { const int st = (r >> 4) * 2 + (c >> 5), rr = r & 15, cc = c & 31, ob = rr * 64 + cc * 2; return st * 1024 + (ob ^ (((ob >> 9) & 1) << 5)); }
__host__ __device__ __forceinline__ void stage_rc(int b, int& R, int& C) { const int st = b / 1024, sb = b % 1024, swz = sb ^ (((sb >> 9) & 1) << 5); R = (st >> 1) * 16 + swz / 64; C = (st & 1) * 32 + (swz % 64) / 2; }
__host__ __device__ __forceinline__ int perm32(int rho) { const int n = rho >> 4, i = rho & 15; return 8 * (i >> 2) + 4 * n + (i & 3); }

struct Unit { int pm, pn; };
struct Gemm { const bf16_t* A; const bf16_t* Bt; int M, N, K; };

struct StaticOrder {
    int nM, nN, nwg, G, c;
    __host__ __device__ void init(int M, int N, int G_, int c_) { nM = M / BM; nN = N / BM; nwg = nM * nN; G = G_; c = c_; }
    __host__ __device__ bool next(int i, Unit& u) const {
        const long L = (long)i * G + c; if (L >= nwg) return false;
        int wgid = (int)L; { const int q = nwg / NXCD, r = nwg % NXCD, xcd = wgid % NXCD, off = wgid / NXCD; wgid = (xcd < r ? xcd * (q + 1) : r * (q + 1) + (xcd - r) * q) + off; }
        const int nig = WGM * nN, gid = wgid / nig, fm = gid * WGM, gsz = (nM - fm) < WGM ? (nM - fm) : WGM;
        u.pm = fm + ((wgid % nig) % gsz); u.pn = (wgid % nig) / gsz;
        u.pn = (u.pn + (int)((L % NXCD) * nN) / NXCD) % nN;
        return true;
    }
    __device__ __forceinline__ void a_ready(const Unit&) const {}
    __device__ __forceinline__ void done(const Unit&) const {}
};

typedef unsigned u32x2 __attribute__((ext_vector_type(2)));
typedef __bf16 bf16x2_t __attribute__((ext_vector_type(2)));
typedef float f32x2_t __attribute__((ext_vector_type(2)));
__device__ __forceinline__ unsigned cvt_pk_bf16(float lo, float hi) { const f32x2_t v = {lo, hi}; const bf16x2_t r = __builtin_convertvector(v, bf16x2_t); return __builtin_bit_cast(unsigned, r); }
__device__ __forceinline__ float bflo(unsigned u) { return __uint_as_float(u << 16); }
__device__ __forceinline__ float bfhi(unsigned u) { return __uint_as_float(u & 0xffff0000u); }
__device__ __forceinline__ float sigmoidf_(float x) { return __builtin_amdgcn_rcpf(1.0f + __expf(-x)); }
__device__ __forceinline__ void st8(bf16_t* p, const f32x4& a, const f32x4& b) {
    u32x4 o; o.x = cvt_pk_bf16(a[0], a[1]); o.y = cvt_pk_bf16(a[2], a[3]); o.z = cvt_pk_bf16(b[0], b[1]); o.w = cvt_pk_bf16(b[2], b[3]); *(u32x4*)p = o; }
__device__ __forceinline__ void ld8(const bf16_t* p, f32x4& a, f32x4& b) {
    const u32x4 v = *(const u32x4*)p; a[0] = bflo(v.x); a[1] = bfhi(v.x); a[2] = bflo(v.y); a[3] = bfhi(v.y); b[0] = bflo(v.z); b[1] = bfhi(v.z); b[2] = bflo(v.w); b[3] = bfhi(v.w); }

enum { EM_A = 0, EM_CONVO = 1, EM_D = 2, EM_RETO = 3, EM_MIXO = 4, EM_UG = 5, EM_DOWN = 6 };
template <int MODE> struct Epi {
    static constexpr bool PERM = true, AFTER_DRAIN = false;
    bf16_t* o[5];
    const bf16_t* i0; const bf16_t* i1;
    const float* f0; const float* f1; const float* f2;
    float* fo;
    __device__ __forceinline__ void operator()(const f32x4 (&acc)[2][2][4][2], const Unit& u, int wr, int wc, int fr, int fq) const {
        const int row0 = u.pm * BM + wr * 64 + fr;
        const int ct = wc * 32 + fq * 8;
        if constexpr (MODE == EM_A) {
            const int ch = u.pn * 64 + wc * 16 + fq * 4;
            const f32x4 w0 = *(const f32x4*)(f1 + ch), w1 = *(const f32x4*)(f1 + DM + ch), w2 = *(const f32x4*)(f1 + 2 * DM + ch), gbias = *(const f32x4*)(f0 + DM + ch);
#pragma unroll
            for (int ai = 0; ai < 2; ++ai) {
                const int blk = (u.pm * BM + ai * HALF + wr * 64) >> 6;
                f32x4 p1 = {0.f, 0.f, 0.f, 0.f}, p2 = p1;
#pragma unroll
                for (int m = 0; m < 4; ++m) { const size_t r = (size_t)(row0 + ai * HALF + m * 16);
                    const f32x4 p = acc[ai][0][m][1] * acc[ai][1][m][0]; f32x4 a1, a2, uu, gg = acc[ai][1][m][1] + gbias;
#pragma unroll
                    for (int e = 0; e < 4; ++e) { a1[e] = __shfl(p[e], (fq << 4) | ((fr + 15) & 15)); a2[e] = __shfl(p[e], (fq << 4) | ((fr + 14) & 15)); }
#pragma unroll
                    for (int e = 0; e < 4; ++e) { const float pv1 = fr >= 1 ? a1[e] : p1[e], pv2 = fr >= 2 ? a2[e] : p2[e];
                        uu[e] = acc[ai][0][m][0][e] * (w0[e] * pv2 + w1[e] * pv1 + w2[e] * p[e]); gg[e] = sigmoidf_(gg[e]); }
                    p1 = a1; p2 = a2;
                    { u32x2 w; w.x = cvt_pk_bf16(uu[0], uu[1]); w.y = cvt_pk_bf16(uu[2], uu[3]); *(u32x2*)(o[0] + r * DM + ch) = w; }
                    { u32x2 w; w.x = cvt_pk_bf16(gg[0], gg[1]); w.y = cvt_pk_bf16(gg[2], gg[3]); *(u32x2*)(o[2] + r * DM + ch) = w; }
                    if (m == 0 && fr < 2) { u32x2 w; w.x = cvt_pk_bf16(p[0], p[1]); w.y = cvt_pk_bf16(p[2], p[3]); *(u32x2*)(o[1] + (size_t)(blk * 2 + fr) * DM + ch) = w;
                        const f32x4 b = acc[ai][0][0][0]; w.x = cvt_pk_bf16(b[0], b[1]); w.y = cvt_pk_bf16(b[2], b[3]); *(u32x2*)(o[3] + (size_t)(blk * 2 + fr) * DM + ch) = w; }
                    if (m == 3 && fr >= 14) { u32x2 w; w.x = cvt_pk_bf16(p[0], p[1]); w.y = cvt_pk_bf16(p[2], p[3]); *(u32x2*)(o[4] + (size_t)(blk * 2 + fr - 14) * DM + ch) = w; } }
            }
        } else if constexpr (MODE == EM_CONVO) {
            const int cb = u.pn * 256 + ct;
#pragma unroll
            for (int ai = 0; ai < 2; ++ai)
#pragma unroll
                for (int m = 0; m < 4; ++m) { const size_t r = (size_t)(row0 + ai * HALF + m * 16);
#pragma unroll
                    for (int bj = 0; bj < 2; ++bj) { f32x4 g0, g1; ld8(i0 + r * DM + cb + bj * HALF, g0, g1);
                        st8(o[0] + r * DM + cb + bj * HALF, acc[ai][bj][m][0] * g0, acc[ai][bj][m][1] * g1); } }
        } else if constexpr (MODE == EM_D) {
            const int seg = u.pn >> 3, hh = u.pn & 7;
            bf16_t* O = seg == 0 ? o[0] : seg == 1 ? o[1] : seg == 2 ? o[2] : seg == 3 ? o[3] : o[4];
            if (seg < 2) {
                const float sc = seg == 0 ? 0.0625f : 1.0f;
#pragma unroll
                for (int ai = 0; ai < 2; ++ai)
#pragma unroll
                    for (int m = 0; m < 4; ++m) { const size_t r = (size_t)(row0 + ai * HALF + m * 16);
                        f32x4 c0 = *(const f32x4*)(f1 + r * 128 + ct), c1 = *(const f32x4*)(f1 + r * 128 + ct + 4);
                        f32x4 s0 = *(const f32x4*)(f2 + r * 128 + ct), s1 = *(const f32x4*)(f2 + r * 128 + ct + 4);
                        c0 *= sc; c1 *= sc; s0 *= sc; s1 *= sc;
                        const f32x4 a0 = acc[ai][0][m][0], a1 = acc[ai][0][m][1], b0 = acc[ai][1][m][0], b1 = acc[ai][1][m][1];
                        st8(O + r * DM + hh * 256 + ct, a0 * c0 - b0 * s0, a1 * c1 - b1 * s1);
                        st8(O + r * DM + hh * 256 + 128 + ct, b0 * c0 + a0 * s0, b1 * c1 + a1 * s1); }
            } else if (seg == 2) {
#pragma unroll
                for (int ai = 0; ai < 2; ++ai)
#pragma unroll
                    for (int m = 0; m < 4; ++m) { const size_t r = (size_t)(row0 + ai * HALF + m * 16);
#pragma unroll
                        for (int bj = 0; bj < 2; ++bj) st8(O + r * DM + hh * 256 + bj * HALF + ct, acc[ai][bj][m][0], acc[ai][bj][m][1]); }
            } else if (seg == 3) {
#pragma unroll
                for (int ai = 0; ai < 2; ++ai)
#pragma unroll
                    for (int m = 0; m < 4; ++m) { const size_t r = (size_t)(row0 + ai * HALF + m * 16);
#pragma unroll
                        for (int bj = 0; bj < 2; ++bj) { f32x4 v0 = acc[ai][bj][m][0], v1 = acc[ai][bj][m][1];
#pragma unroll
                            for (int e = 0; e < 4; ++e) { v0[e] = v0[e] * sigmoidf_(v0[e]); v1[e] = v1[e] * sigmoidf_(v1[e]); }
                            st8(O + r * DM + hh * 256 + bj * HALF + ct, v0, v1); } }
            } else {
                const int cb = hh * 256 + ct;
                f32x4 bv[2][2];
#pragma unroll
                for (int bj = 0; bj < 2; ++bj)
#pragma unroll
                    for (int n = 0; n < 2; ++n) bv[bj][n] = *(const f32x4*)(f0 + cb + bj * HALF + 4 * n);
#pragma unroll
                for (int ai = 0; ai < 2; ++ai)
#pragma unroll
                    for (int m = 0; m < 4; ++m) { const size_t r = (size_t)(row0 + ai * HALF + m * 16);
#pragma unroll
                        for (int bj = 0; bj < 2; ++bj) { f32x4 v0 = acc[ai][bj][m][0] + bv[bj][0], v1 = acc[ai][bj][m][1] + bv[bj][1];
#pragma unroll
                            for (int e = 0; e < 4; ++e) { v0[e] = sigmoidf_(v0[e]); v1[e] = sigmoidf_(v1[e]); }
                            st8(O + r * DM + cb + bj * HALF, v0, v1); } }
            }
        } else if constexpr (MODE == EM_RETO) {
            const int cb = u.pn * 256 + ct;
#pragma unroll
            for (int ai = 0; ai < 2; ++ai)
#pragma unroll
                for (int m = 0; m < 4; ++m) { const size_t r = (size_t)(row0 + ai * HALF + m * 16);
#pragma unroll
                    for (int bj = 0; bj < 2; ++bj) { f32x4 g0, g1, y0, y1; ld8(i0 + r * DM + cb + bj * HALF, g0, g1); ld8(i1 + r * DM + cb + bj * HALF, y0, y1);
                        st8(o[0] + r * DM + cb + bj * HALF, acc[ai][bj][m][0] * g0 + y0, acc[ai][bj][m][1] * g1 + y1); } }
        } else if constexpr (MODE == EM_MIXO) {
            const int cb = u.pn * 256 + ct;
            const int b = (u.pm * BM) / SEQ;
            f32x4 gv[2][2];
#pragma unroll
            for (int bj = 0; bj < 2; ++bj)
#pragma unroll
                for (int n = 0; n < 2; ++n) gv[bj][n] = *(const f32x4*)(f1 + (size_t)b * 6 * DM + cb + bj * HALF + 4 * n);
#pragma unroll
            for (int ai = 0; ai < 2; ++ai)
#pragma unroll
                for (int m = 0; m < 4; ++m) { const size_t r = (size_t)(row0 + ai * HALF + m * 16);
#pragma unroll
                    for (int bj = 0; bj < 2; ++bj) { const size_t off = r * DM + cb + bj * HALF;
                        st8(o[0] + off, *(const f32x4*)(f0 + off) + gv[bj][0] * acc[ai][bj][m][0], *(const f32x4*)(f0 + off + 4) + gv[bj][1] * acc[ai][bj][m][1]); } }
        } else if constexpr (MODE == EM_DOWN) {
            const int cb = u.pn * 256 + ct;
            const int b = (u.pm * BM) / SEQ;
            f32x4 gv[2][2];
#pragma unroll
            for (int bj = 0; bj < 2; ++bj)
#pragma unroll
                for (int n = 0; n < 2; ++n) gv[bj][n] = *(const f32x4*)(f1 + (size_t)b * 6 * DM + cb + bj * HALF + 4 * n);
#pragma unroll
            for (int ai = 0; ai < 2; ++ai)
#pragma unroll
                for (int m = 0; m < 4; ++m) { const size_t r = (size_t)(row0 + ai * HALF + m * 16);
#pragma unroll
                    for (int bj = 0; bj < 2; ++bj) { const size_t off = r * DM + cb + bj * HALF;
                        f32x4 d0, d1; ld8(i0 + off, d0, d1);
                        st8(o[0] + off, d0 + gv[bj][0] * acc[ai][bj][m][0], d1 + gv[bj][1] * acc[ai][bj][m][1]); } }
        } else if constexpr (MODE == EM_UG) {
            const int cb = u.pn * 128 + ct;
            f32x4 w0[2], w1[2], w2[2], bb[2];
#pragma unroll
            for (int n = 0; n < 2; ++n) { w0[n] = *(const f32x4*)(f0 + cb + 4 * n); w1[n] = *(const f32x4*)(f0 + DFF + cb + 4 * n); w2[n] = *(const f32x4*)(f0 + 2 * DFF + cb + 4 * n); bb[n] = *(const f32x4*)(f1 + cb + 4 * n); }
#pragma unroll
            for (int ai = 0; ai < 2; ++ai) {
                const int blk = (u.pm * BM + ai * HALF + wr * 64) >> 6;
                f32x4 p1[2], p2[2];
#pragma unroll
                for (int n = 0; n < 2; ++n) { p1[n] = (f32x4){0.f, 0.f, 0.f, 0.f}; p2[n] = p1[n]; }
#pragma unroll
                for (int m = 0; m < 4; ++m) { const size_t r = (size_t)(row0 + ai * HALF + m * 16);
                    f32x4 out[2];
#pragma unroll
                    for (int n = 0; n < 2; ++n) { const f32x4 g = acc[ai][1][m][n], upv = acc[ai][0][m][n]; f32x4 a1, a2;
#pragma unroll
                        for (int e = 0; e < 4; ++e) { a1[e] = __shfl(g[e], (fq << 4) | ((fr + 15) & 15)); a2[e] = __shfl(g[e], (fq << 4) | ((fr + 14) & 15)); }
#pragma unroll
                        for (int e = 0; e < 4; ++e) { const float pv1 = fr >= 1 ? a1[e] : p1[n][e], pv2 = fr >= 2 ? a2[e] : p2[n][e];
                            const float t = w0[n][e] * pv2 + w1[n][e] * pv1 + w2[n][e] * g[e] + bb[n][e]; out[n][e] = t * sigmoidf_(t) * upv[e]; }
                        p1[n] = a1; p2[n] = a2; }
                    st8(o[0] + r * DFF + cb, out[0], out[1]);
                    if (m == 0 && fr < 2) { st8(o[1] + (size_t)(blk * 2 + fr) * DFF + cb, acc[ai][1][0][0], acc[ai][1][0][1]); st8(o[2] + (size_t)(blk * 2 + fr) * DFF + cb, acc[ai][0][0][0], acc[ai][0][0][1]); }
                    if (m == 3 && fr >= 14) st8(o[3] + (size_t)(blk * 2 + fr - 14) * DFF + cb, acc[ai][1][3][0], acc[ai][1][3][1]); }
            }
        }
    }
};

template <class Epi, class Sched, bool ALIGN_EPI = false, bool SP2 = false>
__device__ __forceinline__ void gemm_phase(PG8_LAS unsigned char* lds, const Gemm g, const Sched& S, const Epi& E) {
    const int tid = threadIdx.x, wid = __builtin_amdgcn_readfirstlane(tid >> 6), lane = tid & 63, wr = wid >> 2, wc = wid & 3, fr = lane & 15, fq = lane >> 4;
    const int K = g.K, nt = K / BK;
    unsigned voffA[2], voffB[2];
#pragma unroll
    for (int i = 0; i < 2; ++i) { int R, C; stage_rc(tid * 16 + i * 8192, R, C); const int Rb = Epi::PERM ? ((R & ~31) + perm32(R & 31)) : R;
        voffA[i] = (unsigned)(R * K + C) * 2u; voffB[i] = (unsigned)(Rb * K + C) * 2u; }
    const size_t kstep = (size_t)(BK * 2);
    const size_t hstep = (size_t)HALF * K * 2;
    const size_t tstep = 2 * hstep;
    const unsigned ldsw = (unsigned)wid * 1024u;
    const int aoff = lds_byte(wr * 64 + fr, fq * 8), boff = lds_byte(wc * 32 + fr, fq * 8);
#define PG8_SA(b, h) (((b) * 2 + (h)) * HTB)
#define PG8_SB(b, h) ((4 + (b) * 2 + (h)) * HTB)
#define PG8_STAGE(bufoff, gbase, voff) do { _Pragma("unroll") for (int _i = 0; _i < 2; ++_i) \
        __builtin_amdgcn_global_load_lds((const unsigned*)((const char*)(gbase) + (voff)[_i]), (PG8_LAS unsigned*)(lds + (bufoff) + ldsw + _i * 8192), 16, 0, 0); } while (0)
#define PG8_LDA(dst, b, h) do { _Pragma("unroll") for (int m = 0; m < 4; ++m) _Pragma("unroll") for (int k = 0; k < 2; ++k) dst[m][k] = *(const PG8_LAS bf16x8*)(lds + PG8_SA(b, h) + aoff + m * 2048 + k * 1024); } while (0)
#define PG8_LDB(dst, b, h) do { _Pragma("unroll") for (int n = 0; n < 2; ++n) _Pragma("unroll") for (int k = 0; k < 2; ++k) dst[n][k] = *(const PG8_LAS bf16x8*)(lds + PG8_SB(b, h) + boff + n * 2048 + k * 1024); } while (0)
#define PG8_MMA(ai, bj, At, Bt) do { __builtin_amdgcn_s_setprio(1); _Pragma("unroll") for (int m = 0; m < 4; ++m) _Pragma("unroll") for (int n = 0; n < 2; ++n) _Pragma("unroll") for (int k = 0; k < 2; ++k) \
        acc[ai][bj][m][n] = __builtin_amdgcn_mfma_f32_16x16x32_bf16(Bt[n][k], At[m][k], acc[ai][bj][m][n], 0, 0, 0); __builtin_amdgcn_s_setprio(0); } while (0)
#define PG8_WAIT_V(n) asm volatile("s_waitcnt vmcnt(" #n ")" ::: "memory")
#define PG8_WAIT_L(n) asm volatile("s_waitcnt lgkmcnt(" #n ")" ::: "memory")
#define PG8_BAR __builtin_amdgcn_s_barrier()
#define PG8_SCHED __builtin_amdgcn_sched_barrier(0)
    Unit cur, nxt; int ui = 0;
    if (!S.next(0, cur)) return;
    f32x4 acc[2][2][4][2];
#pragma unroll
    for (int a = 0; a < 2; ++a)
#pragma unroll
        for (int b = 0; b < 2; ++b)
#pragma unroll
            for (int m = 0; m < 4; ++m)
#pragma unroll
                for (int n = 0; n < 2; ++n) acc[a][b][m][n] = (f32x4){0.f, 0.f, 0.f, 0.f};
    bf16x8 At[4][2], B0[2][2], B1[2][2];
    const char* cA = (const char*)g.A + (size_t)cur.pm * tstep; const char* cB = (const char*)g.Bt + (size_t)cur.pn * tstep;
    S.a_ready(cur);
    if constexpr (SP2) {
        PG8_STAGE(PG8_SB(0, 0), cB, voffB); PG8_STAGE(PG8_SB(0, 1), cB + hstep, voffB); PG8_STAGE(PG8_SA(0, 0), cA, voffA); PG8_STAGE(PG8_SA(0, 1), cA + hstep, voffA);
        if (wr == 1) PG8_BAR;
        PG8_WAIT_V(2); PG8_BAR;
        PG8_STAGE(PG8_SB(1, 0), cB + kstep, voffB); PG8_STAGE(PG8_SA(1, 0), cA + kstep, voffA); PG8_STAGE(PG8_SB(1, 1), cB + hstep + kstep, voffB);
        PG8_WAIT_V(6); PG8_BAR;
    } else {
        PG8_STAGE(PG8_SB(0, 0), cB, voffB); PG8_STAGE(PG8_SA(0, 0), cA, voffA); PG8_STAGE(PG8_SB(0, 1), cB + hstep, voffB); PG8_STAGE(PG8_SA(0, 1), cA + hstep, voffA);
        if (wr == 1) PG8_BAR;
        PG8_WAIT_V(4); PG8_BAR;
        PG8_STAGE(PG8_SB(1, 0), cB + kstep, voffB); PG8_STAGE(PG8_SA(1, 0), cA + kstep, voffA); PG8_STAGE(PG8_SB(1, 1), cB + hstep + kstep, voffB);
        PG8_WAIT_V(6); PG8_BAR;
    }
    for (;;) {
        const bool has_next = S.next(ui + 1, nxt);
        const char* nA = has_next ? (const char*)g.A + (size_t)nxt.pm * tstep : cA; const char* nB = has_next ? (const char*)g.Bt + (size_t)nxt.pn * tstep : cB;
        for (int t = 0; t < nt; t += 2) {
            const bool last = (t == nt - 2);
            const char* a1 = cA + (size_t)(t + 1) * kstep;
            const char* a2 = last ? nA : cA + (size_t)(t + 2) * kstep; const char* b2 = last ? nB : cB + (size_t)(t + 2) * kstep;
            const char* a3 = a2 + kstep; const char* b3 = b2 + kstep;
            if (last && has_next) S.a_ready(nxt);
            if constexpr (SP2) {
            PG8_LDB(B0, 0, 0); PG8_LDB(B1, 0, 1); PG8_SCHED; PG8_LDA(At, 0, 0); PG8_STAGE(PG8_SA(1, 1), a1 + hstep, voffA);
            PG8_WAIT_V(8); PG8_WAIT_L(0); PG8_BAR; PG8_MMA(0, 0, At, B0); PG8_MMA(0, 1, At, B1); PG8_BAR; PG8_SCHED;
            PG8_LDA(At, 0, 1); PG8_STAGE(PG8_SB(0, 0), b2, voffB); PG8_STAGE(PG8_SB(0, 1), b2 + hstep, voffB); PG8_STAGE(PG8_SA(0, 0), a2, voffA);
            PG8_WAIT_V(8); PG8_WAIT_L(0); PG8_BAR; PG8_MMA(1, 0, At, B0); PG8_MMA(1, 1, At, B1); PG8_BAR; PG8_SCHED;
            PG8_LDB(B0, 1, 0); PG8_LDB(B1, 1, 1); PG8_SCHED; PG8_LDA(At, 1, 0); PG8_STAGE(PG8_SA(0, 1), a2 + hstep, voffA);
            PG8_WAIT_V(8); PG8_WAIT_L(0); PG8_BAR; PG8_MMA(0, 0, At, B0); PG8_MMA(0, 1, At, B1); PG8_BAR; PG8_SCHED;
            PG8_LDA(At, 1, 1); PG8_STAGE(PG8_SB(1, 0), b3, voffB); PG8_STAGE(PG8_SB(1, 1), b3 + hstep, voffB); PG8_STAGE(PG8_SA(1, 0), a3, voffA);
            PG8_WAIT_V(8); PG8_WAIT_L(0); PG8_BAR; PG8_MMA(1, 0, At, B0); PG8_MMA(1, 1, At, B1); PG8_BAR; PG8_SCHED;
            } else {
            PG8_LDB(B0, 0, 0); PG8_SCHED; PG8_LDA(At, 0, 0); PG8_STAGE(PG8_SA(1, 1), a1 + hstep, voffA);
            PG8_WAIT_L(8); PG8_BAR; PG8_WAIT_L(0); PG8_MMA(0, 0, At, B0); PG8_BAR; PG8_SCHED;
            PG8_LDB(B1, 0, 1); PG8_STAGE(PG8_SB(0, 0), b2, voffB);
            PG8_BAR; PG8_WAIT_L(0); PG8_MMA(0, 1, At, B1); PG8_BAR;
            PG8_LDA(At, 0, 1); PG8_STAGE(PG8_SA(0, 0), a2, voffA);
            PG8_BAR; PG8_WAIT_L(0); PG8_MMA(1, 0, At, B0); PG8_BAR; PG8_SCHED;
            PG8_STAGE(PG8_SB(0, 1), b2 + hstep, voffB);
            PG8_WAIT_V(6); PG8_BAR; PG8_MMA(1, 1, At, B1); PG8_BAR;
            PG8_LDB(B0, 1, 0); PG8_SCHED; PG8_LDA(At, 1, 0); PG8_STAGE(PG8_SA(0, 1), a2 + hstep, voffA);
            PG8_WAIT_L(8); PG8_BAR; PG8_WAIT_L(0); PG8_MMA(0, 0, At, B0); PG8_BAR; PG8_SCHED;
            PG8_LDB(B1, 1, 1); PG8_STAGE(PG8_SB(1, 0), b3, voffB);
            PG8_BAR; PG8_WAIT_L(0); PG8_MMA(0, 1, At, B1); PG8_BAR;
            PG8_LDA(At, 1, 1); PG8_STAGE(PG8_SA(1, 0), a3, voffA);
            PG8_BAR; PG8_WAIT_L(0); PG8_MMA(1, 0, At, B0); PG8_BAR; PG8_SCHED;
            PG8_STAGE(PG8_SB(1, 1), b3 + hstep, voffB);
            PG8_WAIT_V(6); PG8_BAR; PG8_MMA(1, 1, At, B1); PG8_BAR;
            }
        }
        if constexpr (ALIGN_EPI) { if (wr == 0) PG8_BAR; }
        if constexpr (!Epi::AFTER_DRAIN) { E(acc, cur, wr, wc, fr, fq); S.done(cur); }
        if (!has_next) break;
#pragma unroll
        for (int a = 0; a < 2; ++a)
#pragma unroll
            for (int b = 0; b < 2; ++b)
#pragma unroll
                for (int m = 0; m < 4; ++m)
#pragma unroll
                    for (int n = 0; n < 2; ++n) acc[a][b][m][n] = (f32x4){0.f, 0.f, 0.f, 0.f};
        cur = nxt; cA = nA; cB = nB; ++ui;
        if constexpr (ALIGN_EPI) { if (wr == 1) PG8_BAR; }
    }
    PG8_WAIT_V(0);
    if constexpr (!ALIGN_EPI) { if (wr == 0) PG8_BAR; }
    PG8_BAR;
    if constexpr (Epi::AFTER_DRAIN) { E.fused(acc, cur, wr, wc, fr, fq, lds, wid, lane); S.done(cur); }
#undef PG8_SA
#undef PG8_SB
#undef PG8_STAGE
#undef PG8_LDA
#undef PG8_LDB
#undef PG8_MMA
#undef PG8_WAIT_V
#undef PG8_WAIT_L
#undef PG8_BAR
#undef PG8_SCHED
}
}

#define LAS __attribute__((address_space(3)))
typedef unsigned short bf16_t;
typedef short bf16x8 __attribute__((ext_vector_type(8)));
typedef short s16x4 __attribute__((ext_vector_type(4)));
typedef float f32x4 __attribute__((ext_vector_type(4)));
typedef unsigned u32x4 __attribute__((ext_vector_type(4)));
typedef unsigned u32x2 __attribute__((ext_vector_type(2)));
using pg8::cvt_pk_bf16; using pg8::bflo; using pg8::bfhi; using pg8::sigmoidf_;

constexpr int LDS_XB_OFF = 135168;
constexpr int LDS_BYTES = LDS_XB_OFF + 64;
constexpr size_t WS_XBAR = 896 * 1024;
constexpr size_t MiB = 1u << 20;
constexpr size_t WS_MOD = 0;
constexpr size_t WS_COS = 1 * MiB, WS_SIN = 9 * MiB;
constexpr size_t WS_WIN = 17 * MiB;
constexpr size_t WS_WRO = 89 * MiB, WS_WCO = 97 * MiB, WS_WMO = 105 * MiB;
constexpr size_t WS_S0 = 113 * MiB, WS_S1 = 177 * MiB, WS_S2 = 241 * MiB, WS_S3 = 305 * MiB, WS_S4 = 369 * MiB, WS_S5 = 433 * MiB, WS_S6 = 497 * MiB;
constexpr size_t WS_END = 561 * MiB;
constexpr size_t WS_WUG = 1 * MiB;
constexpr size_t WS_WDN = 45 * MiB;
constexpr size_t WS_XN2 = 67 * MiB, WS_UP = 131 * MiB, WS_GP = 307 * MiB;
constexpr size_t WS_H2 = 307 * MiB;
constexpr size_t WS_HEADG = 435 * MiB, WS_HEADU = 441 * MiB, WS_HALO = 447 * MiB;
constexpr size_t WS_CHEADP = WS_S2, WS_CHEADB = WS_S2 + 2 * MiB, WS_CHALOP = WS_S2 + 4 * MiB;

struct Args { const void* in[19]; float* out; unsigned char* ws; int lo, hi; };

__device__ __forceinline__ float wave_sum(float v) {
#pragma unroll
    for (int o = 1; o < 64; o <<= 1) v += __shfl_xor(v, o);
    return v;
}
#define LDS_WAIT() asm volatile("s_waitcnt lgkmcnt(0)" ::: "memory")

__device__ __forceinline__ void transpose_item(const float* __restrict__ W, int ldw, int k0, int c0, bf16_t* WT, int K, int r0, LAS float* scr, int lane) {
    float tv[32];
#pragma unroll
    for (int i = 0; i < 32; ++i) tv[i] = W[(size_t)(k0 + 2 * i + (lane >> 5)) * ldw + c0 + (lane & 31)];
#pragma unroll
    for (int i = 0; i < 32; ++i) scr[(2 * i + (lane >> 5)) * 33 + (lane & 31)] = tv[i];
    LDS_WAIT();
    const int c = lane & 7;
#pragma unroll
    for (int j = 0; j < 4; ++j) { const int n = (lane >> 3) + 8 * j; const LAS float* s = scr + (8 * c) * 33 + n;
        u32x4 o; o.x = cvt_pk_bf16(s[0 * 33], s[1 * 33]); o.y = cvt_pk_bf16(s[2 * 33], s[3 * 33]); o.z = cvt_pk_bf16(s[4 * 33], s[5 * 33]); o.w = cvt_pk_bf16(s[6 * 33], s[7 * 33]);
        *(u32x4*)(WT + (size_t)(r0 + n) * K + k0 + 8 * c) = o; }
    LDS_WAIT();
}

__device__ __forceinline__ int win_dst_row(int c) {
    const int seg = c >> 11, o = c & 2047;
    switch (seg) {
        case 0: return N_A + o;
        case 1: return N_A + 2048 + o;
        case 2: return N_A + 4096 + o;
        case 3: return N_A + 6144 + o;
        case 7: return N_A + 8192 + o;
        default: {
            const int bj = (seg == 6 || seg == 8) ? 1 : 0, n = (seg == 5 || seg == 8) ? 1 : 0, cl = o & 63;
            return (o >> 6) * 256 + bj * 128 + (cl >> 4) * 32 + ((cl >> 2) & 3) * 8 + n * 4 + (cl & 3); }
    }
}

__device__ __forceinline__ void transpose_item_win(const float* __restrict__ W, int k0, int c0, bf16_t* WT, LAS float* scr, int lane) {
    float tv[32];
#pragma unroll
    for (int i = 0; i < 32; ++i) tv[i] = W[(size_t)(k0 + 2 * i + (lane >> 5)) * 18432 + c0 + (lane & 31)];
#pragma unroll
    for (int i = 0; i < 32; ++i) scr[(2 * i + (lane >> 5)) * 33 + (lane & 31)] = tv[i];
    LDS_WAIT();
    const int c = lane & 7;
#pragma unroll
    for (int j = 0; j < 4; ++j) { const int n = (lane >> 3) + 8 * j; const LAS float* sp = scr + (8 * c) * 33 + n;
        u32x4 o; o.x = cvt_pk_bf16(sp[0 * 33], sp[1 * 33]); o.y = cvt_pk_bf16(sp[2 * 33], sp[3 * 33]); o.z = cvt_pk_bf16(sp[4 * 33], sp[5 * 33]); o.w = cvt_pk_bf16(sp[6 * 33], sp[7 * 33]);
        *(u32x4*)(WT + (size_t)win_dst_row(c0 + n) * DM + k0 + 8 * c) = o; }
    LDS_WAIT();
}

__device__ __forceinline__ void phase0(const Args& a, LAS unsigned char* lds, int G) {
    const int tid = threadIdx.x, lane = tid & 63, wave = tid >> 6, bid = blockIdx.x;
    unsigned char* ws = a.ws;
    {
        LAS float* scr = (LAS float*)(lds + 4096 + wave * 8704);
        const int gw = bid * 8 + wave, NGW = G * 8;
        constexpr int I_IN = 32 * 576, I_SQ = 32 * 64;
        constexpr int NIT = I_IN + 3 * I_SQ;
        bf16_t* Win = (bf16_t*)(ws + WS_WIN);
        for (int it = gw; it < NIT; it += NGW) {
            int r = it;
            if (r < I_IN) { const int kb = r / 576, nb = r % 576; transpose_item_win((const float*)a.in[7], kb * 64, nb * 32, Win, scr, lane); continue; } r -= I_IN;
            if (r < I_SQ) { const int kb = r / 64, nb = r % 64; transpose_item((const float*)a.in[10], DM, kb * 64, nb * 32, (bf16_t*)(ws + WS_WRO), DM, nb * 32, scr, lane); continue; } r -= I_SQ;
            if (r < I_SQ) { const int kb = r / 64, nb = r % 64; transpose_item((const float*)a.in[11], DM, kb * 64, nb * 32, (bf16_t*)(ws + WS_WCO), DM, nb * 32, scr, lane); continue; } r -= I_SQ;
            { const int kb = r / 64, nb = r % 64; transpose_item((const float*)a.in[12], DM, kb * 64, nb * 32, (bf16_t*)(ws + WS_WMO), DM, nb * 32, scr, lane); }
        }
    }
    {
        const int* pos = (const int*)a.in[2];
        float* ct = (float*)(ws + WS_COS); float* st = (float*)(ws + WS_SIN);
        for (int e = bid * 512 + tid; e < MTOK * 128; e += G * 512) {
            const int row = e >> 7, j = e & 127;
            const float inv = exp2f(-(float)j * 0.10381025296523008f);
            const float ang = (float)pos[row] * inv;
            const double t = (double)ang * 0.15915494309189535;
            const float fr = (float)(t - floor(t));
            ct[e] = __builtin_amdgcn_cosf(fr); st[e] = __builtin_amdgcn_sinf(fr);
        }
    }
}

__device__ __forceinline__ void ffn_weights_phase(const Args& a, LAS unsigned char* lds, int G) {
    const int lane = threadIdx.x & 63, wave = threadIdx.x >> 6;
    unsigned char* ws = a.ws;
    LAS float* scr = (LAS float*)(lds + 4096 + wave * 8704);
    const int gw = blockIdx.x * 8 + wave, NGW = G * 8;
    constexpr int I_FF = 32 * 176, I_DN = 88 * 64, NIT = 2 * I_FF + I_DN;
    for (int it = gw; it < NIT; it += NGW) {
        int r = it;
        if (r < I_FF) { const int kb = r / 176, nb = r % 176; transpose_item((const float*)a.in[13], DFF, kb * 64, nb * 32, (bf16_t*)(ws + WS_WUG), DM, (nb >> 2) * 256 + (nb & 3) * 32, scr, lane); continue; } r -= I_FF;
        if (r < I_FF) { const int kb = r / 176, nb = r % 176; transpose_item((const float*)a.in[14], DFF, kb * 64, nb * 32, (bf16_t*)(ws + WS_WUG), DM, (nb >> 2) * 256 + 128 + (nb & 3) * 32, scr, lane); continue; } r -= I_FF;
        { const int kb = r / 64, nb = r % 64; transpose_item((const float*)a.in[17], DM, kb * 64, nb * 32, (bf16_t*)(ws + WS_WDN), DFF, nb * 32, scr, lane); }
    }
}

__device__ __forceinline__ void adaln_phase(const Args& a, LAS unsigned char* lds, int G) {
    const int tid = threadIdx.x;
    const float* c = (const float*)a.in[1]; const float* Wada = (const float*)a.in[5]; const float* bada = (const float*)a.in[6];
    float* mod = (float*)(a.ws + WS_MOD);
    LAS float* cact = (LAS float*)lds;
    LAS f32x4* red = (LAS f32x4*)(lds + 65536);
    for (int i = tid; i < 8 * DM; i += 512) { const float v = c[i]; cact[i] = v * sigmoidf_(v); }
    __syncthreads();
    for (int cb = blockIdx.x; cb < 6 * DM / 48; cb += G) {
        const int cgl = tid % 12, kl = tid / 12;
        if (kl < 42) {
            f32x4 acc[8];
#pragma unroll
            for (int b = 0; b < 8; ++b) acc[b] = (f32x4){0.f, 0.f, 0.f, 0.f};
            const f32x4* wp = (const f32x4*)(Wada + cb * 48 + cgl * 4);
#pragma unroll 7
            for (int k = kl; k < DM; k += 42) { const f32x4 w = wp[(size_t)k * (6 * DM / 4)];
#pragma unroll
                for (int b = 0; b < 8; ++b) acc[b] += w * cact[b * DM + k]; }
#pragma unroll
            for (int b = 0; b < 8; ++b) red[(kl * 12 + cgl) * 8 + b] = acc[b];
        }
        __syncthreads();
        if (tid < 96) { const int cg2 = tid % 12, b = tid / 12;
            f32x4 s = *(const f32x4*)(bada + cb * 48 + cg2 * 4);
            for (int k = 0; k < 42; ++k) s += red[(k * 12 + cg2) * 8 + b];
            *(f32x4*)(mod + (size_t)b * (6 * DM) + cb * 48 + cg2 * 4) = s; }
        __syncthreads();
    }
}

template <bool HAS_DELTA> __device__ __forceinline__ void modnorm_phase(const float* src, const bf16_t* delta, const float* g, const float* mod_sh, const float* mod_sc, bf16_t* dst, int G) {
    const int lane = threadIdx.x & 63, gw = blockIdx.x * 8 + (threadIdx.x >> 6), NGW = G * 8;
    for (int r0 = gw; r0 < MTOK; r0 += 2 * NGW) {
        const bool has1 = r0 + NGW < MTOK; const int rr[2] = {r0, has1 ? r0 + NGW : r0};
        f32x4 v[2][8]; float ss[2] = {0.f, 0.f};
#pragma unroll
        for (int q = 0; q < 2; ++q)
#pragma unroll
            for (int j = 0; j < 8; ++j) {
                if constexpr (HAS_DELTA) { const u32x2 d = *((const u32x2*)(delta + (size_t)rr[q] * DM) + lane + 64 * j); v[q][j][0] = bflo(d.x); v[q][j][1] = bfhi(d.x); v[q][j][2] = bflo(d.y); v[q][j][3] = bfhi(d.y); }
                else v[q][j] = *((const f32x4*)(src + (size_t)rr[q] * DM) + lane + 64 * j); }
#pragma unroll
        for (int q = 0; q < 2; ++q)
#pragma unroll
            for (int j = 0; j < 8; ++j) ss[q] += (v[q][j][0] * v[q][j][0] + v[q][j][1] * v[q][j][1]) + (v[q][j][2] * v[q][j][2] + v[q][j][3] * v[q][j][3]);
        float rstd[2]; rstd[0] = rsqrtf(wave_sum(ss[0]) * (1.0f / DM) + EPS); rstd[1] = rsqrtf(wave_sum(ss[1]) * (1.0f / DM) + EPS);
#pragma unroll
        for (int q = 0; q < 2; ++q) { if (q == 1 && !has1) break;
            const int b = rr[q] >> 11; u32x2* o8 = (u32x2*)(dst + (size_t)rr[q] * DM) + lane;
#pragma unroll
            for (int j = 0; j < 8; ++j) { const int col = 4 * (lane + 64 * j);
                const f32x4 gg = *(const f32x4*)(g + col), sc = *(const f32x4*)(mod_sc + (size_t)b * 6 * DM + col), sh = *(const f32x4*)(mod_sh + (size_t)b * 6 * DM + col);
                const f32x4 y = v[q][j] * rstd[q] * gg * (sc + 1.0f) + sh;
                u32x2 w; w.x = cvt_pk_bf16(y[0], y[1]); w.y = cvt_pk_bf16(y[2], y[3]); o8[64 * j] = w; } }
    }
}

__device__ __forceinline__ void conv_fixup_phase(bf16_t* U, const bf16_t* HEADP, const bf16_t* HEADB, const bf16_t* HALOP, const float* wsc, int G) {
    constexpr int NCG = DM / 8;
    for (int idx = blockIdx.x * 512 + threadIdx.x; idx < (MTOK / 64) * 2 * NCG; idx += G * 512) {
        const int cgp = idx % NCG, br = idx / NCG, B = br >> 1, rr = br & 1, col = cgp * 8;
        const bool seqstart = ((B * 64) & (SEQ - 1)) == 0;
        const f32x4 z = {0.f, 0.f, 0.f, 0.f};
        f32x4 pa, pb, ba, bb, m1a = z, m1b = z, m2a = z, m2b = z;
        pg8::ld8(HEADP + (size_t)(B * 2 + rr) * DM + col, pa, pb); pg8::ld8(HEADB + (size_t)(B * 2 + rr) * DM + col, ba, bb);
        if (rr == 0) { if (!seqstart) { pg8::ld8(HALOP + (size_t)((B - 1) * 2 + 1) * DM + col, m1a, m1b); pg8::ld8(HALOP + (size_t)((B - 1) * 2) * DM + col, m2a, m2b); } }
        else { pg8::ld8(HEADP + (size_t)(B * 2) * DM + col, m1a, m1b); if (!seqstart) pg8::ld8(HALOP + (size_t)((B - 1) * 2 + 1) * DM + col, m2a, m2b); }
        const f32x4 w0a = *(const f32x4*)(wsc + col), w0b = *(const f32x4*)(wsc + col + 4), w1a = *(const f32x4*)(wsc + DM + col), w1b = *(const f32x4*)(wsc + DM + col + 4);
        const f32x4 w2a = *(const f32x4*)(wsc + 2 * DM + col), w2b = *(const f32x4*)(wsc + 2 * DM + col + 4);
        pg8::st8(U + (size_t)(B * 64 + rr) * DM + col, ba * (w0a * m2a + w1a * m1a + w2a * pa), bb * (w0b * m2b + w1b * m1b + w2b * pb));
    }
}

__device__ __forceinline__ void ffn_fixup_phase(bf16_t* ACT, const bf16_t* HEADG, const bf16_t* HEADU, const bf16_t* HALO, const float* wfc, const float* bfc, int G) {
    constexpr int NCG = DFF / 8;
    for (int idx = blockIdx.x * 512 + threadIdx.x; idx < (MTOK / 64) * 2 * NCG; idx += G * 512) {
        const int cgp = idx % NCG, br = idx / NCG, B = br >> 1, rr = br & 1, col = cgp * 8;
        const bool seqstart = ((B * 64) & (SEQ - 1)) == 0;
        const f32x4 z = {0.f, 0.f, 0.f, 0.f};
        f32x4 ga, gb, ua, ub, m1a = z, m1b = z, m2a = z, m2b = z;
        pg8::ld8(HEADG + (size_t)(B * 2 + rr) * DFF + col, ga, gb); pg8::ld8(HEADU + (size_t)(B * 2 + rr) * DFF + col, ua, ub);
        if (rr == 0) { if (!seqstart) { pg8::ld8(HALO + (size_t)((B - 1) * 2 + 1) * DFF + col, m1a, m1b); pg8::ld8(HALO + (size_t)((B - 1) * 2) * DFF + col, m2a, m2b); } }
        else { pg8::ld8(HEADG + (size_t)(B * 2) * DFF + col, m1a, m1b); if (!seqstart) pg8::ld8(HALO + (size_t)((B - 1) * 2 + 1) * DFF + col, m2a, m2b); }
        const f32x4 w0a = *(const f32x4*)(wfc + col), w0b = *(const f32x4*)(wfc + col + 4), w1a = *(const f32x4*)(wfc + DFF + col), w1b = *(const f32x4*)(wfc + DFF + col + 4);
        const f32x4 w2a = *(const f32x4*)(wfc + 2 * DFF + col), w2b = *(const f32x4*)(wfc + 2 * DFF + col + 4), ba = *(const f32x4*)(bfc + col), bb = *(const f32x4*)(bfc + col + 4);
        f32x4 ta = w0a * m2a + w1a * m1a + w2a * ga + ba, tb = w0b * m2b + w1b * m1b + w2b * gb + bb;
#pragma unroll
        for (int e = 0; e < 4; ++e) { ta[e] = ta[e] * sigmoidf_(ta[e]); tb[e] = tb[e] * sigmoidf_(tb[e]); }
        pg8::st8(ACT + (size_t)(B * 64 + rr) * DFF + col, ta * ua, tb * ub);
    }
}

__device__ __forceinline__ void retnorm_phase(bf16_t* Y, const bf16_t* SG, int G) {
    const int lane = threadIdx.x & 63, gw = blockIdx.x * 8 + (threadIdx.x >> 6), NGW = G * 8;
    for (int r0 = gw; r0 < MTOK; r0 += 2 * NGW) {
        const bool has1 = r0 + NGW < MTOK; const int rr[2] = {r0, has1 ? r0 + NGW : r0};
        f32x4 ya[2][4], yb[2][4], ga[2][4], gb[2][4];
#pragma unroll
        for (int q = 0; q < 2; ++q)
#pragma unroll
            for (int c = 0; c < 4; ++c) { const size_t off = (size_t)rr[q] * DM + c * 512 + lane * 8; pg8::ld8(Y + off, ya[q][c], yb[q][c]); pg8::ld8(SG + off, ga[q][c], gb[q][c]); }
#pragma unroll
        for (int q = 0; q < 2; ++q) { if (q == 1 && !has1) break;
#pragma unroll
            for (int c = 0; c < 4; ++c) { const size_t off = (size_t)rr[q] * DM + c * 512 + lane * 8; const f32x4 a = ya[q][c], b = yb[q][c];
                float ss = (a[0] * a[0] + a[1] * a[1]) + (a[2] * a[2] + a[3] * a[3]) + (b[0] * b[0] + b[1] * b[1]) + (b[2] * b[2] + b[3] * b[3]);
#pragma unroll
                for (int o = 1; o < 32; o <<= 1) ss += __shfl_xor(ss, o);
                const float rstd = rsqrtf(ss * (1.0f / 256.0f) + EPS);
                pg8::st8(Y + off, a * rstd * ga[q][c], b * rstd * gb[q][c]); } }
    }
}

__device__ __forceinline__ void final_norm_phase(const bf16_t* H, float* O, const float* g, int G) {
    const int lane = threadIdx.x & 63, gw = blockIdx.x * 8 + (threadIdx.x >> 6), NGW = G * 8;
    for (int r0 = gw; r0 < MTOK; r0 += 2 * NGW) {
        const bool has1 = r0 + NGW < MTOK; const int rr[2] = {r0, has1 ? r0 + NGW : r0};
        u32x2 d[2][8];
#pragma unroll
        for (int q = 0; q < 2; ++q)
#pragma unroll
            for (int j = 0; j < 8; ++j) d[q][j] = *((const u32x2*)(H + (size_t)rr[q] * DM) + lane + 64 * j);
#pragma unroll
        for (int q = 0; q < 2; ++q) { if (q == 1 && !has1) break;
            f32x4 v[8]; float ss = 0.f;
#pragma unroll
            for (int j = 0; j < 8; ++j) { v[j][0] = bflo(d[q][j].x); v[j][1] = bfhi(d[q][j].x); v[j][2] = bflo(d[q][j].y); v[j][3] = bfhi(d[q][j].y); ss += (v[j][0] * v[j][0] + v[j][1] * v[j][1]) + (v[j][2] * v[j][2] + v[j][3] * v[j][3]); }
            const float rstd = rsqrtf(wave_sum(ss) * (1.0f / DM) + EPS);
            f32x4* orow = (f32x4*)(O + (size_t)rr[q] * DM) + lane;
#pragma unroll
            for (int j = 0; j < 8; ++j) { const f32x4 gg = *(const f32x4*)(g + 4 * (lane + 64 * j)); orow[64 * j] = v[j] * rstd * gg; } }
    }
}

constexpr int RS_Q = 560, RS_V = 144;
constexpr int OFF_Q = 0, OFF_K = 64 * RS_Q, OFF_ST = 2 * 64 * RS_Q, OFF_V = 3 * 64 * RS_Q, OFF_P = OFF_V + 64 * RS_V, OFF_V2 = OFF_P + 64 * RS_V;
__device__ __forceinline__ bf16x8 tr8(const LAS unsigned char* p, int stride4) {
    const s16x4 x = __builtin_amdgcn_ds_read_tr16_b64_v4i16((LAS s16x4*)p);
    const s16x4 y = __builtin_amdgcn_ds_read_tr16_b64_v4i16((LAS s16x4*)(p + stride4));
    return (bf16x8){x[0], x[1], x[2], x[3], y[0], y[1], y[2], y[3]};
}
__device__ __forceinline__ f32x4 mfma_k(bf16x8 a, bf16x8 b, f32x4 c) {
    const f32x4 d = __builtin_amdgcn_mfma_f32_16x16x32_bf16(a, b, c, 0, 0, 0);
    asm volatile("" :: "v"(a), "v"(b));
    return d;
}
__device__ __forceinline__ void retention_unit(LAS unsigned char* lds, const bf16_t* Qg, const bf16_t* Kg, const bf16_t* Vg, bf16_t* Yg, int bh, int es) {
    const int tid = threadIdx.x, lane = tid & 63, w = __builtin_amdgcn_readfirstlane(tid >> 6), fr = lane & 15, fq = lane >> 4;
    const int b = bh >> 3, h = bh & 7;
    const float gam = 1.0f - exp2f(-5.0f - (float)h), lg = log2f(gam);
    const size_t base = (size_t)b * SEQ * DM + h * 256;
    const bf16_t* qp = Qg + base; const bf16_t* kp = Kg + base; const bf16_t* vp = Vg + base + es * 64; bf16_t* yp = Yg + base + es * 64;
    const int vrow = tid >> 3, vch = tid & 7;
    const float vsc = exp2f(lg * (float)(63 - vrow));
    const float sdec = exp2f(lg * 64.0f);
    const int it_s = w >> 1, jt0 = (w & 1) * 2;
    const int et = w & 3, itp = (w >> 2) * 2;
    const float pscale = exp2f(lg * (float)(it_s * 16 + fr - 63));
    float ysc[2]; ysc[0] = exp2f(lg * (float)(itp * 16 + fr + 1)); ysc[1] = exp2f(lg * (float)(itp * 16 + 16 + fr + 1));
    const int ql = (lane & 15) >> 2, pl = lane & 3;
    f32x4 sacc[2][4];
#pragma unroll
    for (int d = 0; d < 2; ++d)
#pragma unroll
        for (int e = 0; e < 4; ++e) sacc[d][e] = (f32x4){0.f, 0.f, 0.f, 0.f};
    u32x4 qr[4], kr[4], vr;
#define RET_STAGE(vb) do { _Pragma("unroll") for (int i = 0; i < 4; ++i) { const int p = tid + 512 * i, row = p >> 5, ch = p & 31; \
            *(LAS u32x4*)(lds + OFF_Q + row * RS_Q + ch * 16) = qr[i]; *(LAS u32x4*)(lds + OFF_K + row * RS_Q + ch * 16) = kr[i]; } \
        { u32x4 o; o.x = cvt_pk_bf16(bflo(vr.x) * vsc, bfhi(vr.x) * vsc); o.y = cvt_pk_bf16(bflo(vr.y) * vsc, bfhi(vr.y) * vsc); \
          o.z = cvt_pk_bf16(bflo(vr.z) * vsc, bfhi(vr.z) * vsc); o.w = cvt_pk_bf16(bflo(vr.w) * vsc, bfhi(vr.w) * vsc); \
          *(LAS u32x4*)(lds + ((vb) ? OFF_V2 : OFF_V) + vrow * RS_V + vch * 16) = o; } } while (0)
#define RET_LOAD(c) do { const size_t ro = (size_t)(c) * 64 * DM; _Pragma("unroll") for (int i = 0; i < 4; ++i) { const int p = tid + 512 * i, row = p >> 5, ch = p & 31; \
            qr[i] = *(const u32x4*)(qp + ro + (size_t)row * DM + ch * 8); kr[i] = *(const u32x4*)(kp + ro + (size_t)row * DM + ch * 8); } \
        vr = *(const u32x4*)(vp + ro + (size_t)vrow * DM + vch * 8); } while (0)
    __syncthreads();
    for (int i = tid; i < (64 * RS_Q) / 16; i += 512) *(LAS u32x4*)(lds + OFF_ST + i * 16) = (u32x4){0u, 0u, 0u, 0u};
    RET_LOAD(0);
    RET_STAGE(0);
    __syncthreads();
    for (int c = 0; c < SEQ / 64; ++c) {
        const int vb = c & 1;
        const LAS unsigned char* vcur = lds + (vb ? OFF_V2 : OFF_V);
        if (c + 1 < SEQ / 64) RET_LOAD(c + 1);
        {
            f32x4 sa[2] = {{0.f, 0.f, 0.f, 0.f}, {0.f, 0.f, 0.f, 0.f}};
            if (jt0 <= it_s) {
#pragma unroll
                for (int kk = 0; kk < 8; ++kk) {
                    const bf16x8 bq = *(const LAS bf16x8*)(lds + OFF_Q + (it_s * 16 + fr) * RS_Q + kk * 64 + fq * 16);
                    const bf16x8 a0 = *(const LAS bf16x8*)(lds + OFF_K + (jt0 * 16 + fr) * RS_Q + kk * 64 + fq * 16);
                    const bf16x8 a1 = *(const LAS bf16x8*)(lds + OFF_K + (jt0 * 16 + 16 + fr) * RS_Q + kk * 64 + fq * 16);
                    sa[0] = mfma_k(a0, bq, sa[0]);
                    sa[1] = mfma_k(a1, bq, sa[1]);
                }
            }
            const int i = it_s * 16 + fr;
#pragma unroll
            for (int t = 0; t < 2; ++t) { const int j0 = (jt0 + t) * 16 + 4 * fq;
                float p0 = (i >= j0) ? sa[t][0] * pscale : 0.f, p1 = (i >= j0 + 1) ? sa[t][1] * pscale : 0.f, p2 = (i >= j0 + 2) ? sa[t][2] * pscale : 0.f, p3 = (i >= j0 + 3) ? sa[t][3] * pscale : 0.f;
                u32x2 o; o.x = cvt_pk_bf16(p0, p1); o.y = cvt_pk_bf16(p2, p3);
                *(LAS u32x2*)(lds + OFF_P + i * RS_V + j0 * 2) = o; }
        }
        f32x4 ya[2] = {{0.f, 0.f, 0.f, 0.f}, {0.f, 0.f, 0.f, 0.f}};
#pragma unroll
        for (int kk = 0; kk < 8; ++kk) {
            const bf16x8 as = *(const LAS bf16x8*)(lds + OFF_ST + (et * 16 + fr) * RS_Q + kk * 64 + fq * 16);
            const bf16x8 b0 = *(const LAS bf16x8*)(lds + OFF_Q + (itp * 16 + fr) * RS_Q + kk * 64 + fq * 16);
            const bf16x8 b1 = *(const LAS bf16x8*)(lds + OFF_Q + (itp * 16 + 16 + fr) * RS_Q + kk * 64 + fq * 16);
            ya[0] = mfma_k(as, b0, ya[0]);
            ya[1] = mfma_k(as, b1, ya[1]);
        }
        ya[0] *= ysc[0]; ya[1] *= ysc[1];
#pragma unroll
        for (int d = 0; d < 2; ++d)
#pragma unroll
            for (int e = 0; e < 4; ++e) sacc[d][e] *= sdec;
#pragma unroll
        for (int kk = 0; kk < 2; ++kk) {
            bf16x8 ak[2], bv[4];
#pragma unroll
            for (int d = 0; d < 2; ++d) ak[d] = tr8(lds + OFF_K + (kk * 32 + 8 * fq + ql) * RS_Q + ((2 * w + d) * 16 + 4 * pl) * 2, 4 * RS_Q);
#pragma unroll
            for (int e = 0; e < 4; ++e) bv[e] = tr8(vcur + (kk * 32 + 8 * fq + ql) * RS_V + (e * 16 + 4 * pl) * 2, 4 * RS_V);
#pragma unroll
            for (int d = 0; d < 2; ++d)
#pragma unroll
                for (int e = 0; e < 4; ++e) sacc[d][e] = mfma_k(ak[d], bv[e], sacc[d][e]);
        }
        __syncthreads();
#pragma unroll
        for (int d = 0; d < 2; ++d)
#pragma unroll
            for (int e = 0; e < 4; ++e) { u32x2 o; o.x = cvt_pk_bf16(sacc[d][e][0], sacc[d][e][1]); o.y = cvt_pk_bf16(sacc[d][e][2], sacc[d][e][3]);
                *(LAS u32x2*)(lds + OFF_ST + (e * 16 + fr) * RS_Q + ((2 * w + d) * 16 + 4 * fq) * 2) = o; }
        if (c + 1 < SEQ / 64) { if (vb) RET_STAGE(0); else RET_STAGE(1); }
#pragma unroll
        for (int kk = 0; kk < 2; ++kk) {
            const bf16x8 av = tr8(vcur + (kk * 32 + 8 * fq + ql) * RS_V + (et * 16 + 4 * pl) * 2, 4 * RS_V);
            const bf16x8 b0 = *(const LAS bf16x8*)(lds + OFF_P + (itp * 16 + fr) * RS_V + kk * 64 + fq * 16);
            const bf16x8 b1 = *(const LAS bf16x8*)(lds + OFF_P + (itp * 16 + 16 + fr) * RS_V + kk * 64 + fq * 16);
            ya[0] = mfma_k(av, b0, ya[0]);
            ya[1] = mfma_k(av, b1, ya[1]);
        }
#pragma unroll
        for (int t = 0; t < 2; ++t) { u32x2 o; o.x = cvt_pk_bf16(ya[t][0], ya[t][1]); o.y = cvt_pk_bf16(ya[t][2], ya[t][3]);
            *(u32x2*)(yp + (size_t)(c * 64 + (itp + t) * 16 + fr) * DM + et * 16 + 4 * fq) = o; }
        __syncthreads();
    }
#undef RET_STAGE
#undef RET_LOAD
}
__device__ __forceinline__ void retention_phase(LAS unsigned char* lds, const bf16_t* Q, const bf16_t* K, const bf16_t* V, bf16_t* Y, int G) {
    for (int u0 = blockIdx.x; u0 < 256; u0 += G) {
        const int u = (G == 256) ? ((u0 & 7) * 32 + (u0 >> 3)) : u0;
        retention_unit(lds, Q, K, V, Y, u >> 2, u & 3);
    }
}

#define XB_TMO      128
#define XB_XCNT(j)  (256  + 64 * (j))
#define XB_XSUB(j)  (1280 + 64 * (j))
#define XB_XGEN(j)  (2304 + 64 * (j))
#define XB_TOP      3328
#define XB_TOPGEN   3392
#define XCD_BAR_WORDS 3456
#define XB_SPIN_CAP (1u << 18)

__device__ __forceinline__ unsigned xb_ld(unsigned* p)              { return __hip_atomic_load(p, __ATOMIC_RELAXED, __HIP_MEMORY_SCOPE_AGENT); }
__device__ __forceinline__ unsigned xb_add(unsigned* p, unsigned v) { return __hip_atomic_fetch_add(p, v, __ATOMIC_RELAXED, __HIP_MEMORY_SCOPE_AGENT); }
__device__ __forceinline__ unsigned xb_xcc_id() { return (unsigned)__builtin_amdgcn_s_getreg((3 << 11) | 20) & 0xFu; }
#define XB_SPIN(cond, bar) do { unsigned _sp = 0; while (cond) { __builtin_amdgcn_s_sleep(1); \
    if ((++_sp & 255u) == 0u) { if (xb_ld(&(bar)[XB_TMO])) break; if (_sp > XB_SPIN_CAP) { atomicAdd(&(bar)[XB_TMO], 1u); break; } } } } while (0)

struct XcdBarrier {
    unsigned* bar; unsigned x;
    volatile LAS unsigned* st;
};

__device__ __forceinline__ XcdBarrier xcd_barrier_post(unsigned* bar, volatile LAS unsigned* st) {
    XcdBarrier b; b.bar = bar; b.x = xb_xcc_id(); b.st = st;
    if (threadIdx.x == 0) (void)xb_add(&bar[XB_XCNT(b.x)], 1u);
    return b;
}
__device__ __forceinline__ void xcd_barrier_complete(unsigned* bar, unsigned x, unsigned& nloc, unsigned& nx) {
    const unsigned G = gridDim.x * gridDim.y * gridDim.z;
    unsigned sum, cnt, mine, sp = 0u;
    for (;;) {
        sum = 0u; cnt = 0u; mine = 0u;
#pragma unroll
        for (unsigned j = 0; j < 16; ++j) { const unsigned c = xb_ld(&bar[XB_XCNT(j)]); sum += c; cnt += (c > 0u) ? 1u : 0u; mine = (j == x) ? c : mine; }
        if (sum == G) break;
        __builtin_amdgcn_s_sleep(1);
        if ((++sp & 255u) == 0u) { if (xb_ld(&bar[XB_TMO])) break; if (sp > XB_SPIN_CAP) { atomicAdd(&bar[XB_TMO], 1u); break; } }
    }
    nloc = mine > 0u ? mine : 1u; nx = cnt > 0u ? cnt : 1u;
}

__device__ __forceinline__ void xcd_barrier(const XcdBarrier& b) {
    asm volatile("s_waitcnt vmcnt(0)" ::: "memory");
    __syncthreads();
    if (threadIdx.x == 0) {
        unsigned* bar = b.bar;
        __builtin_amdgcn_s_waitcnt(0);
        unsigned nloc = b.st[0], nx = b.st[1];
        if (nloc == 0u) { xcd_barrier_complete(bar, b.x, nloc, nx); b.st[0] = nloc; b.st[1] = nx; }
        const unsigned old = xb_add(&bar[XB_XSUB(b.x)], 1u);
        const unsigned gen = old / nloc;
        if (old + 1u == (gen + 1u) * nloc) {
            __builtin_amdgcn_fence(__ATOMIC_RELEASE, "agent");
            asm volatile("s_waitcnt vmcnt(0)" ::: "memory");
            const unsigned og = xb_add(&bar[XB_TOP], 1u);
            const unsigned tg = og / nx;
            if (og + 1u == (tg + 1u) * nx) xb_add(&bar[XB_TOPGEN], 1u);
            else XB_SPIN(xb_ld(&bar[XB_TOPGEN]) == tg, bar);
            __builtin_amdgcn_fence(__ATOMIC_ACQUIRE, "agent");
            xb_add(&bar[XB_XGEN(b.x)], 1u);
            asm volatile("s_waitcnt vmcnt(0)" ::: "memory");
        } else {
            XB_SPIN(xb_ld(&bar[XB_XGEN(b.x)]) == gen, bar);
            __builtin_amdgcn_fence(__ATOMIC_ACQUIRE, "agent");
            asm volatile("s_waitcnt vmcnt(0)" ::: "memory");
        }
    }
    __syncthreads();
}


template <int MODE> __device__ __forceinline__ void run_gemm(LAS unsigned char* lds, const bf16_t* A, const bf16_t* Bt, int N, int K, const pg8::Epi<MODE>& E, int G) {
    pg8::Gemm g{A, Bt, MTOK, N, K}; pg8::StaticOrder S; S.init(MTOK, N, G, (int)blockIdx.x);
    pg8::gemm_phase<pg8::Epi<MODE>, pg8::StaticOrder, true, true>(lds, g, S, E);
}

__global__ void __launch_bounds__(512, 2) fwd_megakernel(Args a) {
    extern __shared__ __attribute__((aligned(16))) unsigned char lds_raw[];
    LAS unsigned char* lds = (LAS unsigned char*)lds_raw;
    cg::grid_group grid = cg::this_grid();
    const int G = gridDim.x, lo = a.lo, hi = a.hi;
    unsigned char* ws = a.ws;
    float* mod = (float*)(ws + WS_MOD);
    bf16_t* S0 = (bf16_t*)(ws + WS_S0); bf16_t* S1 = (bf16_t*)(ws + WS_S1); bf16_t* S2 = (bf16_t*)(ws + WS_S2); bf16_t* S3 = (bf16_t*)(ws + WS_S3);
    bf16_t* S4 = (bf16_t*)(ws + WS_S4); bf16_t* S5 = (bf16_t*)(ws + WS_S5); bf16_t* S6 = (bf16_t*)(ws + WS_S6);
    const float* x = (const float*)a.in[0];
#define IN(k) (lo <= (k) && (k) < hi)
#define GSYNC() xcd_barrier(xbar)
#define SEAM(k) do { if ((k) + 1 < hi) GSYNC(); } while (0)

    if (threadIdx.x < 16) ((LAS unsigned*)(lds + LDS_XB_OFF))[threadIdx.x] = 0u;
    __syncthreads();
    const XcdBarrier xbar = xcd_barrier_post((unsigned*)(ws + WS_XBAR), (volatile LAS unsigned*)(lds + LDS_XB_OFF));
    if (hi < 0) grid.sync();
    if (IN(0)) { adaln_phase(a, lds, G); SEAM(0); }
    if (IN(2)) { phase0(a, lds, G); modnorm_phase<false>(x, nullptr, (const float*)a.in[3], mod + 0 * DM, mod + 1 * DM, S0, G); SEAM(2); }
    if (IN(3)) {
        pg8::Epi<pg8::EM_A> E{}; E.o[0] = S1; E.o[1] = (bf16_t*)(ws + WS_CHEADP); E.o[2] = S3; E.o[3] = (bf16_t*)(ws + WS_CHEADB); E.o[4] = (bf16_t*)(ws + WS_CHALOP); E.f0 = (const float*)a.in[8]; E.f1 = (const float*)a.in[9];
        run_gemm<pg8::EM_A>(lds, S0, (const bf16_t*)(ws + WS_WIN), N_A, DM, E, G); SEAM(3); }
    if (IN(4)) { conv_fixup_phase(S1, (const bf16_t*)(ws + WS_CHEADP), (const bf16_t*)(ws + WS_CHEADB), (const bf16_t*)(ws + WS_CHALOP), (const float*)a.in[9], G); SEAM(4); }
    if (IN(5)) {
        pg8::Epi<pg8::EM_CONVO> E{}; E.o[0] = S4; E.i0 = S3;
        run_gemm<pg8::EM_CONVO>(lds, S1, (const bf16_t*)(ws + WS_WCO), DM, DM, E, G); SEAM(5); }
    if (IN(6)) {
        pg8::Epi<pg8::EM_D> E{}; E.o[0] = S1; E.o[1] = S2; E.o[2] = S3; E.o[3] = S5; E.o[4] = S6;
        E.f0 = (const float*)a.in[8]; E.f1 = (const float*)(ws + WS_COS); E.f2 = (const float*)(ws + WS_SIN);
        run_gemm<pg8::EM_D>(lds, S0, (const bf16_t*)(ws + WS_WIN) + (size_t)N_A * DM, N_D, DM, E, G); SEAM(6); }
    if (IN(7)) { retention_phase(lds, S1, S2, S3, S0, G); SEAM(7); }
    if (IN(8)) { retnorm_phase(S0, S5, G); SEAM(8); }
    if (IN(9)) {
        pg8::Epi<pg8::EM_RETO> E{}; E.o[0] = S1; E.i0 = S6; E.i1 = S4;
        run_gemm<pg8::EM_RETO>(lds, S0, (const bf16_t*)(ws + WS_WRO), DM, DM, E, G); SEAM(9); }
    if (IN(10)) {
        pg8::Epi<pg8::EM_MIXO> E{}; E.o[0] = S6; E.f0 = x; E.f1 = mod + 2 * DM;
        run_gemm<pg8::EM_MIXO>(lds, S1, (const bf16_t*)(ws + WS_WMO), DM, DM, E, G); SEAM(10); }
    if (IN(11)) {
        modnorm_phase<true>(x, S6, (const float*)a.in[4], mod + 3 * DM, mod + 4 * DM, (bf16_t*)(ws + WS_XN2), G);
        ffn_weights_phase(a, lds, G); SEAM(11); }
    if (IN(12)) {
        pg8::Epi<pg8::EM_UG> E{}; E.o[0] = (bf16_t*)(ws + WS_UP); E.o[1] = (bf16_t*)(ws + WS_HEADG); E.o[2] = (bf16_t*)(ws + WS_HEADU); E.o[3] = (bf16_t*)(ws + WS_HALO); E.f0 = (const float*)a.in[15]; E.f1 = (const float*)a.in[16];
        run_gemm<pg8::EM_UG>(lds, (const bf16_t*)(ws + WS_XN2), (const bf16_t*)(ws + WS_WUG), N_UG, DM, E, G); SEAM(12); }
    if (IN(13)) { ffn_fixup_phase((bf16_t*)(ws + WS_UP), (const bf16_t*)(ws + WS_HEADG), (const bf16_t*)(ws + WS_HEADU), (const bf16_t*)(ws + WS_HALO), (const float*)a.in[15], (const float*)a.in[16], G); SEAM(13); }
    if (IN(14)) {
        pg8::Epi<pg8::EM_DOWN> E{}; E.o[0] = (bf16_t*)(ws + WS_H2); E.i0 = S6; E.f1 = mod + 5 * DM;
        run_gemm<pg8::EM_DOWN>(lds, (const bf16_t*)(ws + WS_UP), (const bf16_t*)(ws + WS_WDN), DM, DFF, E, G); SEAM(14); }
    if (IN(15)) { final_norm_phase((const bf16_t*)(ws + WS_H2), a.out, (const float*)a.in[18], G); }
}

extern "C" void kernel_launch(void* const* d_in, const int* in_sizes, int n_in, void* d_out, int out_size, void* d_ws, size_t ws_size, hipStream_t stream) {
    static int grid = 0;
    if (grid == 0) {
        if (n_in != 19 || out_size != MTOK * DM || ws_size < WS_END) { fprintf(stderr, "kernel_launch: unexpected shapes (n_in %d out %d ws %zu, need %zu)\n", n_in, out_size, ws_size, (size_t)WS_END); grid = -1; return; }
        int dev = 0, cus = 0, per_cu = 0;
        (void)hipGetDevice(&dev); (void)hipDeviceGetAttribute(&cus, hipDeviceAttributeMultiprocessorCount, dev);
        (void)hipFuncSetAttribute((const void*)fwd_megakernel, hipFuncAttributeMaxDynamicSharedMemorySize, LDS_BYTES);
        (void)hipOccupancyMaxActiveBlocksPerMultiprocessor(&per_cu, fwd_megakernel, 512, LDS_BYTES);
        if (per_cu < 1) { fprintf(stderr, "kernel_launch: occupancy query says %d blocks/CU\n", per_cu); per_cu = 1; }
        grid = cus;
    }
    if (grid < 0) return;
    Args a{};
    for (int i = 0; i < 19; ++i) a.in[i] = d_in[i];
    a.out = (float*)d_out; a.ws = (unsigned char*)d_ws;
#if MK_N_LAUNCHES == 1
    a.lo = 0; a.hi = NPHASE;
    void* params[] = {&a};
    (void)hipMemsetAsync((unsigned char*)d_ws + WS_XBAR, 0, 16384, stream);
    hipError_t e = hipLaunchCooperativeKernel((const void*)fwd_megakernel, dim3(grid), dim3(512), params, LDS_BYTES, stream);
    if (e != hipSuccess) fprintf(stderr, "cooperative launch failed: %s (grid %d)\n", hipGetErrorString(e), grid);
#else
    for (int p = 0; p < NPHASE; ++p) { a.lo = p; a.hi = p + 1; hipLaunchKernelGGL(fwd_megakernel, dim3(grid), dim3(512), LDS_BYTES, stream, a); }
#endif
}
```
